# Optimizing an MI355X kernel written in HIP

```python
import jax, jax.numpy as jnp
from jax import lax
import numpy as np

D_MODEL = 1024
BATCH = 8
SEQ = 4096
DEPTH = 2

GLA_HEADS = 4
GLA_DK = 128
GLA_DV = 128
GLA_RANK = 16
GLA_TAU = 16.0
GLA_CHUNK = 64
CONV_CH = D_MODEL // 2
CONV_K = 3
SWA_Q_HEADS = 8
SWA_KV_HEADS = 2
SWA_HEAD_DIM = 64
SWA_WINDOW = 128
D_FF = 2816
FFN_CONV_K = 3
N_BRANCH = 3
EPS = 1e-6

MIX_SIZES = (
    GLA_HEADS * GLA_DK,
    GLA_HEADS * GLA_DK,
    GLA_HEADS * GLA_DV,
    GLA_HEADS * GLA_DV,
    GLA_RANK,
    CONV_CH,
    CONV_CH,
    CONV_CH,
    SWA_Q_HEADS * SWA_HEAD_DIM,
    SWA_KV_HEADS * SWA_HEAD_DIM,
    SWA_KV_HEADS * SWA_HEAD_DIM,
    N_BRANCH * D_MODEL,
)
D_IN_TOTAL = sum(MIX_SIZES)

kernel_name = 'hybrid_gla_shortconv_swa_sink_block'


def rmsnorm(x, g):
    xf = x.astype(jnp.float32)
    y = xf * lax.rsqrt(jnp.mean(xf * xf, axis=-1, keepdims=True) + EPS)
    return (y * g.astype(jnp.float32)).astype(x.dtype)


def split_columns(z):
    out = []
    off = 0
    for n in MIX_SIZES:
        out.append(z[..., off:off + n])
        off += n
    return out


def causal_dwconv(u, w):
    K = w.shape[0]
    S = u.shape[1]
    up = jnp.pad(u, ((0, 0), (K - 1, 0), (0, 0)))
    y = up[:, 0:S] * w[0]
    for i in range(1, K):
        y = y + up[:, i:i + S] * w[i]
    return y


def alibi_slopes(n_heads):
    return jnp.exp2(-(8.0 / n_heads) * jnp.arange(1, n_heads + 1, dtype=jnp.float32))


def gla_chunked(q, k, v, log_a):
    f32 = jnp.float32
    Bsz, S, H, dk = q.shape
    dv = v.shape[-1]
    C = GLA_CHUNK
    N = S // C
    q = (q.astype(f32) * dk ** -0.5).reshape(Bsz, N, C, H, dk)
    k = k.astype(f32).reshape(Bsz, N, C, H, dk)
    v = v.astype(f32).reshape(Bsz, N, C, H, dv)
    b = jnp.cumsum(log_a.astype(f32).reshape(Bsz, N, C, H, dk), axis=2)
    b_ref = b[:, :, C // 2 - 1:C // 2]
    b_last = b[:, :, C - 1:]
    causal = jnp.tril(jnp.ones((C, C), dtype=bool))
    attn = jnp.einsum('bnihk,bnjhk->bnhij', q * jnp.exp(b - b_ref), k * jnp.exp(b_ref - b))
    attn = jnp.where(causal, attn, 0.0)
    o_intra = jnp.einsum('bnhij,bnjhv->bnihv', attn, v)
    kv = jnp.einsum('bnjhk,bnjhv->bnhkv', k * jnp.exp(b_last - b), v)
    decay = jnp.exp(b_last[:, :, 0])

    def step(state, inp):
        d, kv_n = inp
        return d[..., None] * state + kv_n, state

    s0 = jnp.zeros((Bsz, H, dk, dv), f32)
    _, s_prev = lax.scan(step, s0, (jnp.moveaxis(decay, 1, 0), jnp.moveaxis(kv, 1, 0)))
    s_prev = jnp.moveaxis(s_prev, 0, 1)
    o_inter = jnp.einsum('bnihk,bnhkv->bnihv', q * jnp.exp(b), s_prev)
    return (o_intra + o_inter).reshape(Bsz, S, H, dv)


def swa_sink_attention(q, k, v, sinks, slopes):
    f32 = jnp.float32
    Bsz, S, Hq, hd = q.shape
    Hkv = k.shape[2]
    G = Hq // Hkv
    W = SWA_WINDOW
    Nb = S // W
    qb = (q.astype(f32) * hd ** -0.5).reshape(Bsz, Nb, W, Hkv, G, hd)

    def windows(t):
        tp = jnp.pad(t.astype(f32), ((0, 0), (W, 0), (0, 0), (0, 0))).reshape(Bsz, Nb + 1, W, Hkv, hd)
        return jnp.concatenate([tp[:, :-1], tp[:, 1:]], axis=2)

    kw = windows(k)
    vw = windows(v)
    scores = jnp.einsum('bnqhgd,bnkhd->bnhgqk', qb, kw)
    iq = jnp.arange(W)[:, None]
    jk = jnp.arange(2 * W)[None, :]
    dist = W + iq - jk
    blk = jnp.arange(Nb)[:, None, None]
    valid = (dist >= 0) & (dist < W) & (blk * W - W + jk >= 0)
    alibi = -slopes.reshape(Hkv, G)[:, :, None, None] * dist.astype(f32)
    logits = jnp.where(valid[None, :, None, None], scores + alibi, -jnp.inf)
    sink = sinks.astype(f32).reshape(Hkv, G)[None, None, :, :, None]
    m = jnp.maximum(logits.max(axis=-1), sink)
    p = jnp.exp(logits - m[..., None])
    denom = p.sum(axis=-1) + jnp.exp(sink - m)
    o = jnp.einsum('bnhgqk,bnkhd->bnqhgd', p, vw) / jnp.moveaxis(denom, 4, 2)[..., None]
    return o.reshape(Bsz, S, Hq * hd)


def setup_inputs(seed: int = 0) -> dict:
    key = jax.random.key(seed)
    ks = jax.random.split(key, 17)
    f32 = jnp.float32

    def nrm(k, shape, scale):
        return jax.random.normal(k, shape, f32) * scale

    return {
        'x': nrm(ks[0], (BATCH, SEQ, D_MODEL), 1.0),
        'g_mix': 1.0 + nrm(ks[1], (DEPTH, D_MODEL), 0.02),
        'w_in': nrm(ks[2], (DEPTH, D_MODEL, D_IN_TOTAL), D_MODEL ** -0.5),
        'gla_w_alpha': nrm(ks[3], (DEPTH, GLA_RANK, GLA_HEADS * GLA_DK), GLA_RANK ** -0.5),
        'gla_b_alpha': nrm(ks[4], (DEPTH, GLA_HEADS * GLA_DK), 0.02),
        'gla_norm_g': 1.0 + nrm(ks[5], (DEPTH, GLA_HEADS * GLA_DV), 0.02),
        'conv_w': nrm(ks[6], (DEPTH, CONV_K, CONV_CH), CONV_K ** -0.5),
        'swa_sinks': nrm(ks[7], (DEPTH, SWA_Q_HEADS), 0.5),
        'w_gla_o': nrm(ks[8], (DEPTH, GLA_HEADS * GLA_DV, D_MODEL), (GLA_HEADS * GLA_DV) ** -0.5),
        'w_conv_o': nrm(ks[9], (DEPTH, CONV_CH, D_MODEL), CONV_CH ** -0.5),
        'w_swa_o': nrm(ks[10], (DEPTH, SWA_Q_HEADS * SWA_HEAD_DIM, D_MODEL), (SWA_Q_HEADS * SWA_HEAD_DIM) ** -0.5),
        'w_o': nrm(ks[11], (DEPTH, D_MODEL, D_MODEL), D_MODEL ** -0.5),
        'g_ffn': 1.0 + nrm(ks[12], (DEPTH, D_MODEL), 0.02),
        'w_up': nrm(ks[13], (DEPTH, D_MODEL, 2 * D_FF), D_MODEL ** -0.5),
        'ffn_conv_w': nrm(ks[14], (DEPTH, FFN_CONV_K, 2 * D_FF), FFN_CONV_K ** -0.5),
        'w_down': nrm(ks[15], (DEPTH, D_FF, D_MODEL), D_FF ** -0.5),
        'g_final': 1.0 + nrm(ks[16], (D_MODEL,), 0.02),
    }


def reference(x, g_mix, w_in, gla_w_alpha, gla_b_alpha, gla_norm_g, conv_w, swa_sinks, w_gla_o, w_conv_o, w_swa_o, w_o, g_ffn, w_up, ffn_conv_w, w_down, g_final):
    f32 = jnp.float32
    Bsz, S, _ = x.shape
    slopes = alibi_slopes(SWA_Q_HEADS)
    h = x
    for l in range(DEPTH):
        u = rmsnorm(h, g_mix[l])
        z = u @ w_in[l]
        gq, gk, gv, gr, ga, cx, cb, cc, sq, sk, sv, gates = split_columns(z)

        log_a = jax.nn.log_sigmoid((ga @ gla_w_alpha[l] + gla_b_alpha[l]).astype(f32)) / GLA_TAU
        o = gla_chunked(gq.reshape(Bsz, S, GLA_HEADS, GLA_DK),
                        gk.reshape(Bsz, S, GLA_HEADS, GLA_DK),
                        gv.reshape(Bsz, S, GLA_HEADS, GLA_DV),
                        log_a.reshape(Bsz, S, GLA_HEADS, GLA_DK))
        o = o * lax.rsqrt(jnp.mean(o * o, axis=-1, keepdims=True) + EPS)
        o = o.reshape(Bsz, S, GLA_HEADS * GLA_DV) * gla_norm_g[l].astype(f32)
        y_gla = (o * jax.nn.silu(gr.astype(f32))).astype(x.dtype) @ w_gla_o[l]

        y_conv = (cb * causal_dwconv(cc * cx, conv_w[l])) @ w_conv_o[l]

        o = swa_sink_attention(sq.reshape(Bsz, S, SWA_Q_HEADS, SWA_HEAD_DIM),
                               sk.reshape(Bsz, S, SWA_KV_HEADS, SWA_HEAD_DIM),
                               sv.reshape(Bsz, S, SWA_KV_HEADS, SWA_HEAD_DIM),
                               swa_sinks[l], slopes)
        y_swa = o.astype(x.dtype) @ w_swa_o[l]

        gt = jax.nn.sigmoid(gates)
        merged = (gt[..., :D_MODEL] * y_gla
                  + gt[..., D_MODEL:2 * D_MODEL] * y_conv
                  + gt[..., 2 * D_MODEL:] * y_swa)
        h = h + merged @ w_o[l]

        u = rmsnorm(h, g_ffn[l])
        hid = causal_dwconv(u @ w_up[l], ffn_conv_w[l])
        h = h + (jax.nn.silu(hid[..., :D_FF]) * hid[..., D_FF:]) @ w_down[l]
    return rmsnorm(h, g_final)
```

```cpp
#include <hip/hip_runtime.h>
#include <hip/hip_cooperative_groups.h>
#include <cstdio>
#include <cstdint>
#include <cmath>
namespace cg = cooperative_groups;

#define LAS __attribute__((address_space(3)))
typedef unsigned short bf16_t;
typedef short bf16x8 __attribute__((ext_vector_type(8)));
typedef float f32x4 __attribute__((ext_vector_type(4)));
typedef float f32x2 __attribute__((ext_vector_type(2)));
typedef unsigned u32x4 __attribute__((ext_vector_type(4)));
typedef unsigned u32x2 __attribute__((ext_vector_type(2)));

constexpr int NB = 8, SEQ = 4096, T = NB * SEQ, DM = 1024, DIN = 7440, DFF = 2816, DFF2 = 5632;
constexpr int ZLD = 4608;
constexpr int ZQ = 0, ZK = 512, ZV = 1024, ZR = 1536, ZCX = 2048, ZCB = 2560, ZCC = 3072, ZSQ = 3584, ZSK = 4096, ZSV = 4224, ZGA = 4352;
constexpr float EPS = 1e-6f;
constexpr size_t OW_IN = 0, OW_G = 4718592, OW_GLA = 7864320, OW_CONV = 8388608, OW_SWA = 8912896, OW_O = 9437184, OW_UP = 10485760, OW_DN = 16252928, LAYER_W = 19136512;
constexpr size_t MiB = 1u << 20;
constexpr size_t WS_W = 0, WS_BTOT = 76 * MiB, WS_BAR = 77 * MiB, WS_SSQ = 78 * MiB, WS_U = 80 * MiB, WS_BIG = 144 * MiB, WS_SBUF = 496 * MiB, WS_END = 512 * MiB;
static_assert(2 * LAYER_W * 2 <= WS_BTOT, "weights fit");
constexpr int LDS_BYTES = 147456;
constexpr int NTHREADS = 512;
#ifndef PHM
#define PHM 0xffff
#endif

__device__ __forceinline__ unsigned f2bf(float f) { unsigned u = __builtin_bit_cast(unsigned, f); return (u + 0x7fffu + ((u >> 16) & 1u)) >> 16; }
__device__ __forceinline__ unsigned pk2(float lo, float hi) { return f2bf(lo) | (f2bf(hi) << 16); }
__device__ __forceinline__ float bf2f(bf16_t h) { return __builtin_bit_cast(float, (unsigned)h << 16); }
__device__ __forceinline__ float bflo(unsigned w) { return __builtin_bit_cast(float, w << 16); }
__device__ __forceinline__ float bfhi(unsigned w) { return __builtin_bit_cast(float, w & 0xffff0000u); }
__device__ __forceinline__ unsigned cvt_pk_bf16(float lo, float hi) { unsigned r; asm volatile("s_nop 1\n\tv_cvt_pk_bf16_f32 %0, %1, %2" : "=v"(r) : "v"(lo), "v"(hi)); return r; }
__device__ __forceinline__ unsigned hwbf(float f) { return cvt_pk_bf16(f, 0.f) & 0xffffu; }
__device__ __forceinline__ float wave_sum(float v) {
#pragma unroll
    for (int o = 1; o < 64; o <<= 1) v += __shfl_xor(v, o);
    return v;
}
__device__ __forceinline__ float sigmoidf_(float x) { return __builtin_amdgcn_rcpf(1.0f + __expf(-x)); }
__device__ __forceinline__ float siluf_(float x) { return x * __builtin_amdgcn_rcpf(1.0f + __expf(-x)); }
#define LDS_WAIT() asm volatile("s_waitcnt lgkmcnt(0)" ::: "memory")
__device__ __forceinline__ int fresh_tid() { int t = threadIdx.x; asm volatile("" : "+v"(t)); return t; }

namespace pg8 {
constexpr int BM = 256, BK = 64, HALF = 128, HTB = HALF * BK * 2, STAGE_BYTES = 8 * HTB, NXCD = 8, WGM = 8;
__host__ __device__ __forceinline__ int lds_byte(int r, int c) { const int st = (r >> 4) * 2 + (c >> 5), rr = r & 15, cc = c & 31, ob = rr * 64 + cc * 2; return st * 1024 + (ob ^ (((ob >> 9) & 1) << 5)); }
__host__ __device__ __forceinline__ void stage_rc(int b, int& R, int& C) { const int st = b / 1024, sb = b % 1024, swz = sb ^ (((sb >> 9) & 1) << 5); R = (st >> 1) * 16 + swz / 64; C = (st & 1) * 32 + (swz % 64) / 2; }
__host__ __device__ __forceinline__ int perm32(int rho) { const int n = rho >> 4, i = rho & 15; return 8 * (i >> 2) + 4 * n + (i & 3); }

struct Unit { int pm, pn, seg; };
struct Gemm { const bf16_t* A0; const bf16_t* A1; const bf16_t* A2; const bf16_t* B0; const bf16_t* B1; const bf16_t* B2; };

template <int NSEG, int N_> struct StaticOrder {
    static constexpr int nM = T / BM, nN = N_ / BM, nwg = nM * nN;
    int G, c;
    __device__ __forceinline__ void init(int G_, int c_) { G = G_; c = c_; }
    __device__ __forceinline__ bool next(int i, Unit& u) const {
        const int ti = (NSEG == 1) ? i : i / NSEG; u.seg = (NSEG == 1) ? 0 : i - ti * NSEG;
        const long L = (long)ti * G + c; if (L >= nwg) return false;
        int wgid = (int)L; { const int q = nwg / NXCD, r = nwg % NXCD, xcd = wgid % NXCD, off = wgid / NXCD; wgid = (xcd < r ? xcd * (q + 1) : r * (q + 1) + (xcd - r) * q) + off; }
        const int nig = WGM * nN, gid = wgid / nig, fm = gid * WGM, gsz = (nM - fm) < WGM ? (nM - fm) : WGM;
        u.pm = fm + ((wgid % nig) % gsz); u.pn = (wgid % nig) / gsz; return true;
    }
};


__device__ __forceinline__ void scale_rows(f32x4 (&acc)[2][2][4][2], const float* ssq, const Unit& u, int wr, int fr, int fq) {
    f32x4 p[2][4];
#pragma unroll
    for (int ai = 0; ai < 2; ++ai)
#pragma unroll
        for (int m = 0; m < 4; ++m) { const size_t r = (size_t)(u.pm * BM + ai * HALF + wr * 64 + m * 16 + fr); p[ai][m] = *(const f32x4*)(ssq + ((size_t)fq * T + r) * 4); }
#pragma unroll
    for (int ai = 0; ai < 2; ++ai)
#pragma unroll
        for (int m = 0; m < 4; ++m) { float sq = (p[ai][m].x + p[ai][m].y) + (p[ai][m].z + p[ai][m].w);
            sq += __shfl_xor(sq, 16); sq += __shfl_xor(sq, 32);
            const float rs = __builtin_amdgcn_rsqf(sq * (1.0f / DM) + EPS);
#pragma unroll
            for (int bj = 0; bj < 2; ++bj)
#pragma unroll
                for (int n = 0; n < 2; ++n) acc[ai][bj][m][n] = acc[ai][bj][m][n] * rs; }
}

template <int MODE  > struct EpiBf16 {
    static constexpr bool PERM = true, ALIGN = true;
    bf16_t* O; int ldc; const float* ssq;
    __device__ __forceinline__ bool keep(const Unit&) const { return false; }
    __device__ __forceinline__ static int gate_zcol(int tile) {
        return tile < 4 ? tile * 256 : tile < 6 ? 1024 + (tile - 4) * 256 : tile < 8 ? ZCX + (tile - 6) * 256 : tile < 10 ? ZCC + (tile - 8) * 256 : tile == 10 ? ZSK : ZGA;
    }
    __device__ __forceinline__ void operator()(f32x4 (&acc)[2][2][4][2], const Unit& u, int wr, int wc, int fr, int fq) const {
        scale_rows(acc, ssq, u, wr, fr, fq);
        const int row0 = u.pm * BM + wr * 64 + fr;
        const int colt = (MODE == 1) ? gate_zcol(u.pn) : u.pn * BM;
        const int col0 = colt + wc * 32 + 8 * fq;
#pragma unroll
        for (int ai = 0; ai < 2; ++ai)
#pragma unroll
            for (int m = 0; m < 4; ++m) { bf16_t* rowp = O + (size_t)(row0 + ai * HALF + m * 16) * ldc + col0;
#pragma unroll
                for (int bj = 0; bj < 2; ++bj) { f32x4 v0 = acc[ai][bj][m][0], v1 = acc[ai][bj][m][1];
                    if (MODE == 1) {
                        unsigned g0 = 0u, g1 = 0u;
#pragma unroll
                        for (int e = 0; e < 4; ++e) { g0 = __builtin_amdgcn_cvt_pk_u8_f32(fmaxf(floorf(255.f * sigmoidf_(v0[e]) + 0.5f), 1.f), e, g0);
                                                      g1 = __builtin_amdgcn_cvt_pk_u8_f32(fmaxf(floorf(255.f * sigmoidf_(v1[e]) + 0.5f), 1.f), e, g1); }
                        *(u32x2*)((unsigned char*)O + ((size_t)(row0 + ai * HALF + m * 16) * ldc + colt) * 2 + bj * HALF + wc * 32 + 8 * fq) = (u32x2){g0, g1};
                    } else {
                    if (u.pn * BM + bj * HALF + wc * 32 + 8 * fq < ZGA + 16) {
                    u32x4 w; w.x = cvt_pk_bf16(v0[0], v0[1]); w.y = cvt_pk_bf16(v0[2], v0[3]); w.z = cvt_pk_bf16(v1[0], v1[1]); w.w = cvt_pk_bf16(v1[2], v1[3]);
                    *(u32x4*)(rowp + bj * HALF) = w; } } } }
    }
};

struct EpiMerge {
    static constexpr bool PERM = true, ALIGN = true;
    const bf16_t* Zg; bf16_t* O; int ldc;
    __device__ __forceinline__ bool keep(const Unit& u) const { return u.seg != 2; }
    __device__ __forceinline__ void operator()(f32x4 (&acc)[2][2][4][2], const Unit& u, int wr, int wc, int fr, int fq) const {
        const int row0 = u.pm * BM + wr * 64 + fr;
        const int seg = u.seg;
        const int gnum = EpiBf16<1>::gate_zcol(4 * seg + u.pn) * 2 + wc * 32 + 8 * fq;
        const int gden = EpiBf16<1>::gate_zcol(4 * (seg < 2 ? seg + 1 : 2) + u.pn) * 2 + wc * 32 + 8 * fq;
        const int col0 = u.pn * BM + wc * 32 + 8 * fq;
        const unsigned char* Zb = (const unsigned char*)Zg;
        u32x2 gnv[2][4][2], gdv[2][4][2];
#pragma unroll
        for (int ai = 0; ai < 2; ++ai)
#pragma unroll
            for (int m = 0; m < 4; ++m) { const size_t r = (size_t)(row0 + ai * HALF + m * 16);
#pragma unroll
                for (int bj = 0; bj < 2; ++bj) { gnv[ai][m][bj] = *(const u32x2*)(Zb + r * (ZLD * 2) + gnum + bj * HALF);
                    gdv[ai][m][bj] = (seg < 2) ? *(const u32x2*)(Zb + r * (ZLD * 2) + gden + bj * HALF) : (u32x2){0u, 0u}; } }
#pragma unroll
        for (int ai = 0; ai < 2; ++ai) {
#pragma unroll
            for (int m = 0; m < 4; ++m) { const size_t r = (size_t)(row0 + ai * HALF + m * 16);
#pragma unroll
                for (int bj = 0; bj < 2; ++bj) {
                    const u32x2 gn = gnv[ai][m][bj], gd = gdv[ai][m][bj];
                    float f[8];
#pragma unroll
                    for (int e = 0; e < 4; ++e) { f[e] = (float)((gn.x >> (8 * e)) & 0xffu); f[4 + e] = (float)((gn.y >> (8 * e)) & 0xffu); }
                    if (seg < 2) {
#pragma unroll
                        for (int e = 0; e < 4; ++e) { f[e] = f[e] * __builtin_amdgcn_rcpf((float)((gd.x >> (8 * e)) & 0xffu)); f[4 + e] = f[4 + e] * __builtin_amdgcn_rcpf((float)((gd.y >> (8 * e)) & 0xffu)); }
                    } else {
#pragma unroll
                        for (int e = 0; e < 8; ++e) f[e] = f[e] * (1.0f / 255.0f);
                    }
                    f32x4 v0 = acc[ai][bj][m][0], v1 = acc[ai][bj][m][1];
#pragma unroll
                    for (int e = 0; e < 4; ++e) { v0[e] *= f[e]; v1[e] *= f[4 + e]; }
                    acc[ai][bj][m][0] = v0; acc[ai][bj][m][1] = v1;
                    if (seg == 2) {
                        u32x4 w; w.x = cvt_pk_bf16(v0[0], v0[1]); w.y = cvt_pk_bf16(v0[2], v0[3]); w.z = cvt_pk_bf16(v1[0], v1[1]); w.w = cvt_pk_bf16(v1[2], v1[3]);
                        *(u32x4*)(O + r * ldc + col0 + bj * HALF) = w;
                    }
                } }
        }
    }
};

#define DPPF(v, ctrl) __builtin_bit_cast(float, __builtin_amdgcn_update_dpp(0, __builtin_bit_cast(int, (v)), (ctrl), 0xf, 0xf, true))
struct EpiAct {
    static constexpr bool PERM = true, ALIGN = true;
    bf16_t* ACT; float* PRE; const float* fw; LAS unsigned char* xch; const float* ssq;
    __device__ __forceinline__ bool keep(const Unit&) const { return false; }
    __device__ __forceinline__ void operator()(f32x4 (&acc)[2][2][4][2], const Unit& u, int wr, int wc, int fr, int fq) const {
        LAS float* X = (LAS float*)xch;
        const int chb = u.pn * 128 + wc * 32 + 8 * fq;
        f32x4 wq[3][2];
#pragma unroll
        for (int k = 0; k < 3; ++k)
#pragma unroll
            for (int bj = 0; bj < 2; ++bj) wq[k][bj] = *(const f32x4*)(fw + k * DFF2 + bj * DFF + chb);
        {
            LAS float* RS = X + 2048;
            const int lane_e = fq * 16 + fr;
            if (lane_e < 32) { const int rr = (wr * 4 + wc) * 32 + lane_e; const float* sp = ssq + (size_t)(u.pm * BM + rr) * 4;
                const f32x4 a0 = *(const f32x4*)sp, a1 = *(const f32x4*)(sp + (size_t)T * 4), a2 = *(const f32x4*)(sp + (size_t)T * 8), a3 = *(const f32x4*)(sp + (size_t)T * 12);
                const float sq = ((a0.x + a0.y) + (a0.z + a0.w)) + ((a1.x + a1.y) + (a1.z + a1.w)) + ((a2.x + a2.y) + (a2.z + a2.w)) + ((a3.x + a3.y) + (a3.z + a3.w));
                RS[rr] = __builtin_amdgcn_rsqf(sq * (1.0f / DM) + EPS); }
            asm volatile("s_waitcnt lgkmcnt(0)" ::: "memory"); __builtin_amdgcn_s_barrier(); asm volatile("" ::: "memory");
#pragma unroll
            for (int ai = 0; ai < 2; ++ai)
#pragma unroll
                for (int m = 0; m < 4; ++m) { const float rs = RS[ai * HALF + wr * 64 + m * 16 + fr];
#pragma unroll
                    for (int bj = 0; bj < 2; ++bj)
#pragma unroll
                        for (int n = 0; n < 2; ++n) acc[ai][bj][m][n] = acc[ai][bj][m][n] * rs; }
        }
        if (fr >= 14) {
#pragma unroll
            for (int ai = 0; ai < 2; ++ai) { LAS float* p = X + ((((ai * 2 + wr) * 4 + wc) * 2 + (fr - 14)) * 4 + fq) * 16;
#pragma unroll
                for (int bj = 0; bj < 2; ++bj)
#pragma unroll
                    for (int n = 0; n < 2; ++n) *(LAS f32x4*)(p + bj * 8 + n * 4) = acc[ai][bj][3][n]; }
            if (wr == 1) { float* q = PRE + ((size_t)u.pm * 4 + 2 + (fr - 14)) * DFF2 + chb;
#pragma unroll
                for (int bj = 0; bj < 2; ++bj)
#pragma unroll
                    for (int n = 0; n < 2; ++n) *(f32x4*)(q + bj * DFF + 4 * n) = acc[1][bj][3][n]; }
        }
        if (wr == 0 && fr < 2) { float* q = PRE + ((size_t)u.pm * 4 + fr) * DFF2 + chb;
#pragma unroll
            for (int bj = 0; bj < 2; ++bj)
#pragma unroll
                for (int n = 0; n < 2; ++n) *(f32x4*)(q + bj * DFF + 4 * n) = acc[0][bj][0][n]; }
        asm volatile("s_waitcnt lgkmcnt(0)" ::: "memory"); __builtin_amdgcn_s_barrier(); asm volatile("" ::: "memory");
#pragma unroll
        for (int n = 0; n < 2; ++n) {
            f32x4 w[3][2];
#pragma unroll
            for (int k = 0; k < 3; ++k)
#pragma unroll
                for (int bj = 0; bj < 2; ++bj) w[k][bj] = (n == 0) ? wq[k][bj] : *(const f32x4*)(fw + k * DFF2 + bj * DFF + chb + 4);
#pragma unroll
            for (int ai = 0; ai < 2; ++ai)
#pragma unroll
                for (int m = 0; m < 4; ++m) {
                    f32x4 t1[2], t2[2];
                    if (m > 0) {
#pragma unroll
                        for (int bj = 0; bj < 2; ++bj)
#pragma unroll
                            for (int e = 0; e < 4; ++e) { const float pv = acc[ai][bj][m - 1][n][e]; t1[bj][e] = DPPF(pv, 0x10F); t2[bj][e] = DPPF(pv, 0x10E); }
                    } else {
                        const bool has_pred = (wr == 1) || (ai == 1);
                        const int pai = (wr == 1) ? ai : 0, pwr = (wr == 1) ? 0 : 1;
                        const LAS float* p14 = X + ((((pai * 2 + pwr) * 4 + wc) * 2 + 0) * 4 + fq) * 16; const LAS float* p15 = p14 + 64;
#pragma unroll
                        for (int bj = 0; bj < 2; ++bj) { const f32x4 r14 = *(const LAS f32x4*)(p14 + bj * 8 + n * 4), r15 = *(const LAS f32x4*)(p15 + bj * 8 + n * 4);
#pragma unroll
                            for (int e = 0; e < 4; ++e) { t1[bj][e] = (has_pred && fr == 0) ? r15[e] : 0.f; t2[bj][e] = has_pred ? (fr == 0 ? r14[e] : (fr == 1 ? r15[e] : 0.f)) : 0.f; } }
                    }
                    float h[2][4];
#pragma unroll
                    for (int bj = 0; bj < 2; ++bj)
#pragma unroll
                        for (int e = 0; e < 4; ++e) { const float cur = acc[ai][bj][m][n][e];
                            const float p1 = DPPF(cur, 0x111) + t1[bj][e], p2 = DPPF(cur, 0x112) + t2[bj][e];
                            h[bj][e] = w[0][bj][e] * p2 + w[1][bj][e] * p1 + w[2][bj][e] * cur; }
                    float r4[4];
#pragma unroll
                    for (int c = 0; c < 4; ++c) r4[c] = siluf_(h[0][c]) * h[1][c];
                    const bool skip = (ai == 0) && (m == 0) && (wr == 0) && (fr < 2);
                    if (!skip) { u32x2 o; o.x = cvt_pk_bf16(r4[0], r4[1]); o.y = cvt_pk_bf16(r4[2], r4[3]);
                        *(u32x2*)(ACT + (size_t)(u.pm * BM + ai * HALF + wr * 64 + m * 16 + fr) * DFF + chb + 4 * n) = o; }
                }
            asm volatile("" ::: "memory");
        }
    }
};

struct EpiResid {
    static constexpr bool PERM = false, ALIGN = false;
    const float* basef; const bf16_t* baseb; float* out; int ldc; bf16_t* hb; float* ssq;
    __device__ __forceinline__ bool keep(const Unit&) const { return false; }
    __device__ __forceinline__ void operator()(f32x4 (&acc)[2][2][4][2], const Unit& u, int wr, int wc, int fr, int fq) const {
        const int col0 = u.pn * BM + wc * 32 + 4 * fq;
#pragma unroll
        for (int ai = 0; ai < 2; ++ai) {
            u32x2 bb[4][2][2];
            if (!basef) {
#pragma unroll
                for (int m = 0; m < 4; ++m) { const size_t off = (size_t)(u.pm * BM + ai * HALF + wr * 64 + m * 16 + fr) * ldc + col0;
#pragma unroll
                    for (int bj = 0; bj < 2; ++bj)
#pragma unroll
                        for (int n = 0; n < 2; ++n) bb[m][bj][n] = *(const u32x2*)(baseb + off + bj * HALF + n * 16); }
            }
#pragma unroll
            for (int m = 0; m < 4; ++m) { const size_t row = (size_t)(u.pm * BM + ai * HALF + wr * 64 + m * 16 + fr); const size_t off = row * ldc + col0; float sq = 0.f;
#pragma unroll
                for (int bj = 0; bj < 2; ++bj)
#pragma unroll
                    for (int n = 0; n < 2; ++n) { f32x4 bs;
                        if (basef) bs = *(const f32x4*)(basef + off + bj * HALF + n * 16);
                        else { const u32x2 b2 = bb[m][bj][n]; bs = (f32x4){bflo(b2.x), bfhi(b2.x), bflo(b2.y), bfhi(b2.y)}; }
                        const f32x4 v = bs + acc[ai][bj][m][n];
                        if (out) *(f32x4*)(out + off + bj * HALF + n * 16) = v;
                        if (hb) { sq += (v.x * v.x + v.y * v.y) + (v.z * v.z + v.w * v.w); *(u32x2*)(hb + off + bj * HALF + n * 16) = (u32x2){cvt_pk_bf16(v.x, v.y), cvt_pk_bf16(v.z, v.w)}; } }
                if (hb) { sq += __shfl_xor(sq, 16); sq += __shfl_xor(sq, 32); if (fq == 0) ssq[((size_t)u.pn * T + row) * 4 + wc] = sq; } }
            asm volatile("" ::: "memory");
        }
    }
};

template <class Epi, class Sched, int NSEG, int KK, int LDA, int LDB>
__device__ __forceinline__ void gemm_phase(LAS unsigned char* lds, const Gemm g, const Sched& S, const Epi& E) {
    const int tid = fresh_tid(), wid = __builtin_amdgcn_readfirstlane(tid >> 6), lane = tid & 63, wr = wid >> 2, wc = wid & 3, fr = lane & 15, fq = lane >> 4;
    constexpr int nt = KK / BK;
    unsigned voffA[2], voffB[2];
#pragma unroll
    for (int i = 0; i < 2; ++i) { int R, C; stage_rc(tid * 16 + i * 8192, R, C); const int Rb = Epi::PERM ? ((R & ~31) + perm32(R & 31)) : R;
        voffA[i] = (unsigned)(R * LDA + C) * 2u; voffB[i] = (unsigned)(Rb * LDB + C) * 2u; }
    constexpr size_t kstep = (size_t)(BK * 2);
    constexpr size_t hstepA = (size_t)HALF * LDA * 2, hstepB = (size_t)HALF * LDB * 2;
    constexpr size_t tstepA = 2 * hstepA, tstepB = 2 * hstepB;
    const unsigned ldsw = (unsigned)wid * 1024u;
    const int aoff = lds_byte(wr * 64 + fr, fq * 8), boff = lds_byte(wc * 32 + fr, fq * 8);
#define PG8_SA(b, h) (((b) * 2 + (h)) * HTB)
#define PG8_SB(b, h) ((4 + (b) * 2 + (h)) * HTB)
#define PG8_STAGE(bufoff, gbase, voff) do { _Pragma("unroll") for (int _i = 0; _i < 2; ++_i) \
        __builtin_amdgcn_global_load_lds((const unsigned*)((const char*)(gbase) + (voff)[_i]), (LAS unsigned*)(lds + (bufoff) + ldsw + _i * 8192), 16, 0, 0); } while (0)
#define PG8_LDA(dst, b, h) do { _Pragma("unroll") for (int m = 0; m < 4; ++m) _Pragma("unroll") for (int k = 0; k < 2; ++k) dst[m][k] = *(const LAS bf16x8*)(lds + PG8_SA(b, h) + aoff + m * 2048 + k * 1024); } while (0)
#define PG8_LDB(dst, b, h) do { _Pragma("unroll") for (int n = 0; n < 2; ++n) _Pragma("unroll") for (int k = 0; k < 2; ++k) dst[n][k] = *(const LAS bf16x8*)(lds + PG8_SB(b, h) + boff + n * 2048 + k * 1024); } while (0)
#define PG8_MMA(ai, bj, At, Bt) do { __builtin_amdgcn_s_setprio(1); _Pragma("unroll") for (int m = 0; m < 4; ++m) _Pragma("unroll") for (int n = 0; n < 2; ++n) _Pragma("unroll") for (int k = 0; k < 2; ++k) \
        acc[ai][bj][m][n] = __builtin_amdgcn_mfma_f32_16x16x32_bf16(Bt[n][k], At[m][k], acc[ai][bj][m][n], 0, 0, 0); __builtin_amdgcn_s_setprio(0); } while (0)
#define PG8_WAIT_V(n) asm volatile("s_waitcnt vmcnt(" #n ")" ::: "memory")
#define PG8_WAIT_L(n) asm volatile("s_waitcnt lgkmcnt(" #n ")" ::: "memory")
#define PG8_BAR __builtin_amdgcn_s_barrier()
#define PG8_SCHED __builtin_amdgcn_sched_barrier(0)
#define PG8_APTR(u) ((const char*)((NSEG == 1 || (u).seg == 0) ? g.A0 : (u).seg == 1 ? g.A1 : g.A2) + (size_t)(u).pm * tstepA)
#define PG8_BPTR(u) ((const char*)((NSEG == 1 || (u).seg == 0) ? g.B0 : (u).seg == 1 ? g.B1 : g.B2) + (size_t)(u).pn * tstepB)
    Unit cur, nxt; int ui = 0;
    if (!S.next(0, cur)) return;
    f32x4 acc[2][2][4][2];
#pragma unroll
    for (int a = 0; a < 2; ++a)
#pragma unroll
        for (int b = 0; b < 2; ++b)
#pragma unroll
            for (int m = 0; m < 4; ++m)
#pragma unroll
                for (int n = 0; n < 2; ++n) acc[a][b][m][n] = (f32x4){0.f, 0.f, 0.f, 0.f};
    bf16x8 At[4][2], B0[2][2], B1[2][2];
    const char* cA = PG8_APTR(cur); const char* cB = PG8_BPTR(cur);
    PG8_STAGE(PG8_SB(0, 0), cB, voffB); PG8_STAGE(PG8_SB(0, 1), cB + hstepB, voffB); PG8_STAGE(PG8_SA(0, 0), cA, voffA); PG8_STAGE(PG8_SA(0, 1), cA + hstepA, voffA);
    if (wr == 1) PG8_BAR;
    PG8_WAIT_V(2); PG8_BAR;
    PG8_STAGE(PG8_SB(1, 0), cB + kstep, voffB); PG8_STAGE(PG8_SA(1, 0), cA + kstep, voffA); PG8_STAGE(PG8_SB(1, 1), cB + hstepB + kstep, voffB);
    PG8_WAIT_V(6); PG8_BAR;
    for (;;) {
        const bool has_next = S.next(ui + 1, nxt);
        const char* nA = has_next ? PG8_APTR(nxt) : cA; const char* nB = has_next ? PG8_BPTR(nxt) : cB;
        for (int t = 0; t < nt; t += 2) {
            const bool last = (t == nt - 2);
            const char* a1 = cA + (size_t)(t + 1) * kstep;
            const char* a2 = last ? nA : cA + (size_t)(t + 2) * kstep; const char* b2 = last ? nB : cB + (size_t)(t + 2) * kstep;
            const char* a3 = a2 + kstep; const char* b3 = b2 + kstep;
            PG8_LDB(B0, 0, 0); PG8_LDB(B1, 0, 1); PG8_SCHED; PG8_LDA(At, 0, 0); PG8_STAGE(PG8_SA(1, 1), a1 + hstepA, voffA);
            PG8_WAIT_V(8); PG8_WAIT_L(0); PG8_BAR; PG8_MMA(0, 0, At, B0); PG8_MMA(0, 1, At, B1); PG8_BAR; PG8_SCHED;
            PG8_LDA(At, 0, 1); PG8_STAGE(PG8_SB(0, 0), b2, voffB); PG8_STAGE(PG8_SB(0, 1), b2 + hstepB, voffB); PG8_STAGE(PG8_SA(0, 0), a2, voffA);
            PG8_WAIT_V(8); PG8_WAIT_L(0); PG8_BAR; PG8_MMA(1, 0, At, B0); PG8_MMA(1, 1, At, B1); PG8_BAR; PG8_SCHED;
            PG8_LDB(B0, 1, 0); PG8_LDB(B1, 1, 1); PG8_SCHED; PG8_LDA(At, 1, 0); PG8_STAGE(PG8_SA(0, 1), a2 + hstepA, voffA);
            PG8_WAIT_V(8); PG8_WAIT_L(0); PG8_BAR; PG8_MMA(0, 0, At, B0); PG8_MMA(0, 1, At, B1); PG8_BAR; PG8_SCHED;
            PG8_LDA(At, 1, 1); PG8_STAGE(PG8_SB(1, 0), b3, voffB); PG8_STAGE(PG8_SB(1, 1), b3 + hstepB, voffB); PG8_STAGE(PG8_SA(1, 0), a3, voffA);
            PG8_WAIT_V(8); PG8_WAIT_L(0); PG8_BAR; PG8_MMA(1, 0, At, B0); PG8_MMA(1, 1, At, B1); PG8_BAR; PG8_SCHED;
        }
        if (Epi::ALIGN) { if (wr == 0) PG8_BAR; }
        { const int t_e = fresh_tid(); int fr_e = t_e & 15, fq_e = (t_e >> 4) & 3; int wr_e = wr, wc_e = wc; asm volatile("" : "+s"(wr_e), "+s"(wc_e));
          E(acc, cur, wr_e, wc_e, fr_e, fq_e); }
        if (!has_next) break;
        if (!E.keep(cur)) {
#pragma unroll
            for (int a = 0; a < 2; ++a)
#pragma unroll
                for (int b = 0; b < 2; ++b)
#pragma unroll
                    for (int m = 0; m < 4; ++m)
#pragma unroll
                        for (int n = 0; n < 2; ++n) acc[a][b][m][n] = (f32x4){0.f, 0.f, 0.f, 0.f};
        }
        cur = nxt; cA = nA; cB = nB; ++ui;
        if (Epi::ALIGN) { if (wr == 1) PG8_BAR; }
    }
    PG8_WAIT_V(0);
    if (!Epi::ALIGN) { if (wr == 0) PG8_BAR; }
    PG8_BAR;
#undef PG8_SA
#undef PG8_SB
#undef PG8_STAGE
#undef PG8_LDA
#undef PG8_LDB
#undef PG8_MMA
#undef PG8_WAIT_V
#undef PG8_WAIT_L
#undef PG8_BAR
#undef PG8_SCHED
#undef PG8_APTR
#undef PG8_BPTR
}
}

template <bool UPMAP = false>
__device__ __forceinline__ void transpose_item(const float* W, int ldw, int ncols, bf16_t* WT, int K, int row_off, LAS float* scr, int item, int lane, const float* gk = nullptr) {
    const int nblk = ncols / 32, kb = item / nblk, nb = item % nblk, k0 = 64 * kb, n0 = 32 * nb;
    if (UPMAP) { const int c2 = n0 < DFF ? n0 : n0 - DFF; row_off = 256 * (c2 >> 7) + (n0 < DFF ? 0 : 128) + (c2 & 127) - n0; }
#pragma unroll
    for (int i = 0; i < 32; ++i) { const int kk = 2 * i + (lane >> 5); float wv = W[(size_t)(k0 + kk) * ldw + n0 + (lane & 31)]; if (gk) wv *= gk[k0 + kk]; scr[kk * 33 + (lane & 31)] = wv; }
    LDS_WAIT(); asm volatile("" ::: "memory");
    const int c = lane & 7;
#pragma unroll
    for (int j = 0; j < 4; ++j) { const int n = (lane >> 3) + 8 * j; const LAS float* s = scr + (8 * c) * 33 + n;
        u32x4 o; o.x = pk2(s[0 * 33], s[1 * 33]); o.y = pk2(s[2 * 33], s[3 * 33]); o.z = pk2(s[4 * 33], s[5 * 33]); o.w = pk2(s[6 * 33], s[7 * 33]);
        *(u32x4*)(WT + (size_t)(row_off + n0 + n) * K + k0 + 8 * c) = o; }
    LDS_WAIT(); asm volatile("" ::: "memory");
}
__device__ __forceinline__ void rms_row_to_bf16(const float* xrow, const float* g, bf16_t* orow, int lane) {
    const f32x4* xr = (const f32x4*)xrow + lane; const f32x4* gr = (const f32x4*)g + lane;
    f32x4 v[4]; float s = 0.f;
#pragma unroll
    for (int j = 0; j < 4; ++j) { v[j] = xr[64 * j]; s += (v[j].x * v[j].x + v[j].y * v[j].y) + (v[j].z * v[j].z + v[j].w * v[j].w); }
    const float rstd = 1.0f / sqrtf(wave_sum(s) * (1.f / DM) + EPS);
    unsigned long long* o8 = (unsigned long long*)orow + lane;
#pragma unroll
    for (int j = 0; j < 4; ++j) { const f32x4 gg = gr[64 * j];
        o8[64 * j] = (unsigned long long)pk2(v[j].x * rstd * gg.x, v[j].y * rstd * gg.y) | ((unsigned long long)pk2(v[j].z * rstd * gg.z, v[j].w * rstd * gg.w) << 32); }
}
__device__ __forceinline__ void rms_2rows_to_bf16(const float* x0, const float* x1, const float* g, bf16_t* o0, bf16_t* o1, int lane) {
    const f32x4* xa = (const f32x4*)x0 + lane; const f32x4* xb = (const f32x4*)x1 + lane; const f32x4* gr = (const f32x4*)g + lane;
    f32x4 va[4], vb[4]; float sa = 0.f, sb = 0.f;
#pragma unroll
    for (int j = 0; j < 4; ++j) { va[j] = xa[64 * j]; vb[j] = xb[64 * j]; }
#pragma unroll
    for (int j = 0; j < 4; ++j) { sa += (va[j].x * va[j].x + va[j].y * va[j].y) + (va[j].z * va[j].z + va[j].w * va[j].w); sb += (vb[j].x * vb[j].x + vb[j].y * vb[j].y) + (vb[j].z * vb[j].z + vb[j].w * vb[j].w); }
    const float ra = 1.0f / sqrtf(wave_sum(sa) * (1.f / DM) + EPS), rb = 1.0f / sqrtf(wave_sum(sb) * (1.f / DM) + EPS);
    unsigned long long* pa = (unsigned long long*)o0 + lane; unsigned long long* pb = (unsigned long long*)o1 + lane;
#pragma unroll
    for (int j = 0; j < 4; ++j) { const f32x4 gg = gr[64 * j];
        pa[64 * j] = (unsigned long long)pk2(va[j].x * ra * gg.x, va[j].y * ra * gg.y) | ((unsigned long long)pk2(va[j].z * ra * gg.z, va[j].w * ra * gg.w) << 32);
        pb[64 * j] = (unsigned long long)pk2(vb[j].x * rb * gg.x, vb[j].y * rb * gg.y) | ((unsigned long long)pk2(vb[j].z * rb * gg.z, vb[j].w * rb * gg.w) << 32); }
}
__device__ __forceinline__ void rms_row_f32_inplace(float* xrow, const float* g, int lane) {
    f32x4* xr = (f32x4*)xrow + lane; const f32x4* gr = (const f32x4*)g + lane;
    f32x4 v[4]; float s = 0.f;
#pragma unroll
    for (int j = 0; j < 4; ++j) { v[j] = xr[64 * j]; s += (v[j].x * v[j].x + v[j].y * v[j].y) + (v[j].z * v[j].z + v[j].w * v[j].w); }
    const float rstd = 1.0f / sqrtf(wave_sum(s) * (1.f / DM) + EPS);
#pragma unroll
    for (int j = 0; j < 4; ++j) { const f32x4 gg = gr[64 * j]; xr[64 * j] = v[j] * rstd * gg; }
}

__device__ __forceinline__ f32x4 mfma16(bf16x8 a, bf16x8 b, f32x4 c) { return __builtin_amdgcn_mfma_f32_16x16x32_bf16(a, b, c, 0, 0, 0); }

template <bool FULL>
__device__ __forceinline__ void gla_segment(LAS unsigned char* L, bf16_t* Z, const float* w_alpha, const float* b_alpha, const float* norm_g, int unit, float* Sbuf, float* Btot) {
    const int tid = fresh_tid(), lane = tid & 63, w = tid >> 6, quad = lane >> 4, l15 = lane & 15;
    const int kcol = tid & 127, qtr = tid >> 7;
    const int b = unit >> 5, h = (unit >> 3) & 3, seg = unit & 7;
    LAS bf16_t* QI = (LAS bf16_t*)(L + 0);
    LAS bf16_t* KI = (LAS bf16_t*)(L + 17408);
    LAS float*  OL = (LAS float*)(L + 0);
    LAS bf16_t* QT = (LAS bf16_t*)(L + 34816);
    LAS bf16_t* KTt = (LAS bf16_t*)(L + 52224);
    LAS bf16_t* Vt = (LAS bf16_t*)(L + 70656);
    LAS bf16_t* Pm = (LAS bf16_t*)(L + 89088);
    LAS bf16_t* St = (LAS bf16_t*)(L + 98304);
    LAS float*  GAs = (LAS float*)(L + 133120);
    LAS float*  PART = (LAS float*)(L + 137216);
    LAS float*  Dd = (LAS float*)(L + 139264);

    float wa[16];
#pragma unroll
    for (int r = 0; r < 16; ++r) wa[r] = w_alpha[r * 512 + h * 128 + kcol];
    const float ba = b_alpha[h * 128 + kcol];
    f32x4 S[8];
#pragma unroll
    for (int t = 0; t < 8; ++t) S[t] = (f32x4){0.f, 0.f, 0.f, 0.f};
    float btot = 0.f;
    if (FULL) {
        if (seg > 0) {
            float cv[32], cb4[4], nv[32], nb4[4];
            { const int up = unit - seg; const float* sb = Sbuf + (size_t)up * 16384 + tid;
#pragma unroll
              for (int j = 0; j < 4; ++j) cb4[j] = Btot[up * 128 + w * 16 + quad * 4 + j];
#pragma unroll
              for (int q = 0; q < 32; ++q) cv[q] = sb[q * 512]; }
            for (int sp = 0; sp < seg; ++sp) {
                const bool hn = sp + 1 < seg; const int upn = unit - seg + (hn ? sp + 1 : sp); const float* sbn = Sbuf + (size_t)upn * 16384 + tid;
#pragma unroll
                for (int j = 0; j < 4; ++j) nb4[j] = Btot[upn * 128 + w * 16 + quad * 4 + j];
#pragma unroll
                for (int q = 0; q < 32; ++q) nv[q] = sbn[q * 512];
                float d[4];
#pragma unroll
                for (int j = 0; j < 4; ++j) d[j] = __expf(cb4[j]);
#pragma unroll
                for (int t = 0; t < 8; ++t)
#pragma unroll
                    for (int j = 0; j < 4; ++j) S[t][j] = S[t][j] * d[j] + cv[t * 4 + j];
#pragma unroll
                for (int j = 0; j < 4; ++j) cb4[j] = nb4[j];
#pragma unroll
                for (int q = 0; q < 32; ++q) cv[q] = nv[q];
            }
        }
#pragma unroll
        for (int t = 0; t < 8; ++t) *(LAS u32x2*)(St + (t * 16 + l15) * 136 + w * 16 + quad * 4) = (u32x2){pk2(S[t][0], S[t][1]), pk2(S[t][2], S[t][3])}    ;
    }
    __syncthreads();

    unsigned short qraw[16], kraw[16], vraw[16], garaw[2], knx[16], vnx[16], ganx[2];
#define GLA_ISSUE(nn) do { const size_t tb_ = (size_t)b * SEQ + (size_t)(seg * 8 + (nn)) * 64; const bf16_t* zq_ = Z + (tb_ + qtr * 16) * ZLD + h * 128 + kcol; \
        _Pragma("unroll") for (int r = 0; r < 16; ++r) { asm volatile("" : "+v"(zq_)); if (FULL) { qraw[r] = zq_[ZQ]; kraw[r] = zq_[ZK]; vraw[r] = zq_[ZV]; } else { knx[r] = zq_[ZK]; vnx[r] = zq_[ZV]; } zq_ += ZLD; } \
        const unsigned short g0_ = Z[(tb_ + (tid >> 4)) * ZLD + ZGA + (tid & 15)], g1_ = Z[(tb_ + 32 + (tid >> 4)) * ZLD + ZGA + (tid & 15)]; \
        if (FULL) { garaw[0] = g0_; garaw[1] = g1_; } else { ganx[0] = g0_; ganx[1] = g1_; } } while (0)
#define GLA_ROTATE() do { if (!FULL) { _Pragma("unroll") for (int r = 0; r < 16; ++r) { kraw[r] = knx[r]; vraw[r] = vnx[r]; } garaw[0] = ganx[0]; garaw[1] = ganx[1]; } } while (0)
    GLA_ISSUE(0); GLA_ROTATE();
    for (int n = 0; n < 8; ++n) {
        const size_t tb = (size_t)b * SEQ + (size_t)(seg * 8 + n) * 64;
        if (!FULL && n + 1 < 8) GLA_ISSUE(n + 1);
        GAs[tid] = bf2f(garaw[0]); GAs[tid + 512] = bf2f(garaw[1]);
        __syncthreads();
        float c[16]; float run = 0.f;
#pragma unroll
        for (int r = 0; r < 16; ++r) { const int i = qtr * 16 + r;
            const LAS f32x4* gp = (const LAS f32x4*)(GAs + i * 16);
            f32x2 a2 = (f32x2){ba, 0.f};
#pragma unroll
            for (int q4 = 0; q4 < 4; ++q4) { const f32x4 g4 = gp[q4];
                a2 = a2 + (f32x2){g4.x, g4.y} * (f32x2){wa[4 * q4], wa[4 * q4 + 1]}; a2 = a2 + (f32x2){g4.z, g4.w} * (f32x2){wa[4 * q4 + 2], wa[4 * q4 + 3]}; }
            const float x = a2.x + a2.y;
            const float ls = fminf(x, 0.f) - __logf(1.0f + __expf(-fabsf(x)));
            run += ls * (1.0f / 16.0f); c[r] = run; }
        PART[qtr * 128 + kcol] = run;
        __syncthreads();
        const float p0 = PART[kcol], p1 = PART[128 + kcol], p2 = PART[256 + kcol], p3 = PART[384 + kcol];
        const float off = (qtr > 0 ? p0 : 0.f) + (qtr > 1 ? p1 : 0.f) + (qtr > 2 ? p2 : 0.f);
        const float bref = p0 + p1, blast = (p0 + p1) + (p2 + p3);
        btot += blast;
        {
            const float ebr = __expf(bref), elb = __expf(blast - bref);
            unsigned ktp[8], vp[8];
#pragma unroll
            for (int r = 0; r < 16; ++r) { const int i = qtr * 16 + r; const float bi = off + c[r];
                const float e1 = __expf(bi - bref), e1r = __expf(bref - bi);
                const float k = bf2f(kraw[r]); const unsigned vb = vraw[r];
                if (FULL) { const float q = bf2f(qraw[r]) * 0.08838834764831845f;
                    QI[i * 136 + kcol] = (bf16_t)hwbf(q * e1); KI[i * 136 + kcol] = (bf16_t)hwbf(k * e1r); QT[i * 136 + kcol] = (bf16_t)hwbf(q * e1 * ebr); }
                const unsigned kt = hwbf(k * e1r * elb);
                if (r & 1) { ktp[r >> 1] |= kt << 16; vp[r >> 1] |= vb << 16; } else { ktp[r >> 1] = kt; vp[r >> 1] = vb; } }
            *(LAS u32x4*)(KTt + kcol * 72 + qtr * 16) = (u32x4){ktp[0], ktp[1], ktp[2], ktp[3]}; *(LAS u32x4*)(KTt + kcol * 72 + qtr * 16 + 8) = (u32x4){ktp[4], ktp[5], ktp[6], ktp[7]};
            *(LAS u32x4*)(Vt + kcol * 72 + qtr * 16) = (u32x4){vp[0], vp[1], vp[2], vp[3]}; *(LAS u32x4*)(Vt + kcol * 72 + qtr * 16 + 8) = (u32x4){vp[4], vp[5], vp[6], vp[7]};
            if (qtr == 0) Dd[kcol] = __expf(blast);
        }
        __syncthreads();
        if (FULL && n + 1 < 8) GLA_ISSUE(n + 1);
        const int oi = tid >> 3, vs = (tid & 7) * 16;
        bf16_t* zr = Z + (tb + oi) * ZLD + ZR + h * 128 + vs;
        u32x4 g8[2];
        if (FULL) { g8[0] = *(const u32x4*)zr; g8[1] = *(const u32x4*)(zr + 8); }
        if (FULL) {
            {
                const int mi = w >> 1;
#pragma unroll
                for (int nn = 0; nn < 2; ++nn) { const int nj = (w & 1) * 2 + nn; f32x4 a4 = (f32x4){0.f, 0.f, 0.f, 0.f};
#pragma unroll
                    for (int ks = 0; ks < 4; ++ks) a4 = mfma16(*(const LAS bf16x8*)(QI + (mi * 16 + l15) * 136 + ks * 32 + quad * 8), *(const LAS bf16x8*)(KI + (nj * 16 + l15) * 136 + ks * 32 + quad * 8), a4);
#pragma unroll
                    for (int j = 0; j < 4; ++j) { const int i = mi * 16 + quad * 4 + j, jj = nj * 16 + l15; Pm[i * 72 + jj] = (bf16_t)hwbf(jj <= i ? a4[j] : 0.f); } }
            }
            __syncthreads();
            {
                const int mi = w >> 1; f32x4 o4[4];
#pragma unroll
                for (int t = 0; t < 4; ++t) o4[t] = (f32x4){0.f, 0.f, 0.f, 0.f};
#pragma unroll
                for (int ks = 0; ks < 2; ++ks) { const bf16x8 a = *(const LAS bf16x8*)(Pm + (mi * 16 + l15) * 72 + ks * 32 + quad * 8);
#pragma unroll
                    for (int t = 0; t < 4; ++t) { const int nv = (w & 1) * 4 + t; o4[t] = mfma16(a, *(const LAS bf16x8*)(Vt + (nv * 16 + l15) * 72 + ks * 32 + quad * 8), o4[t]); } }
#pragma unroll
                for (int ks = 0; ks < 4; ++ks) { const bf16x8 a = *(const LAS bf16x8*)(QT + (mi * 16 + l15) * 136 + ks * 32 + quad * 8);
#pragma unroll
                    for (int t = 0; t < 4; ++t) { const int nv = (w & 1) * 4 + t; o4[t] = mfma16(a, *(const LAS bf16x8*)(St + (nv * 16 + l15) * 136 + ks * 32 + quad * 8), o4[t]); } }
#pragma unroll
                for (int t = 0; t < 4; ++t) { const int nv = (w & 1) * 4 + t;
#pragma unroll
                    for (int j = 0; j < 4; ++j) OL[(mi * 16 + quad * 4 + j) * 132 + nv * 16 + l15] = o4[t][j]; }
            }
            __syncthreads();
        }
        {
            float dk[4];
#pragma unroll
            for (int j = 0; j < 4; ++j) dk[j] = Dd[w * 16 + quad * 4 + j];
            bf16x8 ka[2];
#pragma unroll
            for (int ks = 0; ks < 2; ++ks) ka[ks] = *(const LAS bf16x8*)(KTt + (w * 16 + l15) * 72 + ks * 32 + quad * 8);
#pragma unroll
            for (int t = 0; t < 8; ++t) {
#pragma unroll
                for (int j = 0; j < 4; ++j) S[t][j] *= dk[j];
#pragma unroll
                for (int ks = 0; ks < 2; ++ks) S[t] = mfma16(ka[ks], *(const LAS bf16x8*)(Vt + (t * 16 + l15) * 72 + ks * 32 + quad * 8), S[t]);
                if (FULL) *(LAS u32x2*)(St + (t * 16 + l15) * 136 + w * 16 + quad * 4) = (u32x2){pk2(S[t][0], S[t][1]), pk2(S[t][2], S[t][3])}    ;
            }
        }
        if (FULL) {
            f32x4 ov[4]; float ss = 0.f;
#pragma unroll
            for (int e = 0; e < 4; ++e) { ov[e] = *(const LAS f32x4*)(OL + oi * 132 + vs + 4 * e); ss += (ov[e].x * ov[e].x + ov[e].y * ov[e].y) + (ov[e].z * ov[e].z + ov[e].w * ov[e].w); }
            ss += __shfl_xor(ss, 1); ss += __shfl_xor(ss, 2); ss += __shfl_xor(ss, 4);
            const float rstd = __builtin_amdgcn_rsqf(ss * (1.0f / 128.0f) + EPS);
            const float* ng = norm_g + h * 128 + vs;
#pragma unroll
            for (int hh = 0; hh < 2; ++hh) {
                const float gr[8] = {bflo(g8[hh].x), bfhi(g8[hh].x), bflo(g8[hh].y), bfhi(g8[hh].y), bflo(g8[hh].z), bfhi(g8[hh].z), bflo(g8[hh].w), bfhi(g8[hh].w)};
                const f32x4 n0 = *(const f32x4*)(ng + 8 * hh), n1 = *(const f32x4*)(ng + 8 * hh + 4);
                const f32x4 a0 = ov[2 * hh], a1 = ov[2 * hh + 1];
                float r8[8];
#pragma unroll
                for (int e = 0; e < 4; ++e) { r8[e] = a0[e] * rstd * n0[e] * siluf_(gr[e]); r8[4 + e] = a1[e] * rstd * n1[e] * siluf_(gr[4 + e]); }
                *(u32x4*)(zr + 8 * hh) = (u32x4){cvt_pk_bf16(r8[0], r8[1]), cvt_pk_bf16(r8[2], r8[3]), cvt_pk_bf16(r8[4], r8[5]), cvt_pk_bf16(r8[6], r8[7])}; }
        }
        if (n + 1 < 8) GLA_ROTATE();
    }
    if (!FULL) {
        float* sb = Sbuf + (size_t)unit * 16384 + tid;
#pragma unroll
        for (int t = 0; t < 8; ++t)
#pragma unroll
            for (int j = 0; j < 4; ++j) sb[(t * 4 + j) * 512] = S[t][j];
        if (qtr == 0) Btot[unit * 128 + kcol] = btot;
    }
    __syncthreads();
}


__device__ __forceinline__ void swa_unit(LAS unsigned char* L, bf16_t* Z, const float* sinks, int b, int qb, int kvh) {
    const int tid = fresh_tid(), lane = tid & 63, w = tid >> 6, quad = lane >> 4, l15 = lane & 15;
    LAS bf16_t* Ks = (LAS bf16_t*)(L + 0);
    LAS bf16_t* Vt = (LAS bf16_t*)(L + 36864);
    LAS bf16_t* Pw = (LAS bf16_t*)(L + 72704 + w * 5376);
    const int t0 = qb * 128; const size_t rowbase = (size_t)b * SEQ;
    const int g = w >> 1, hq = kvh * 4 + g, half = w & 1;
    bf16x8 qf[4][2];
#pragma unroll
    for (int rt = 0; rt < 4; ++rt) { const bf16_t* qp = Z + (rowbase + t0 + 64 * half + 16 * rt + l15) * ZLD + ZSQ + hq * 64 + quad * 8; qf[rt][0] = *(const bf16x8*)qp; qf[rt][1] = *(const bf16x8*)(qp + 32); }
    for (int idx = tid; idx < 2048; idx += NTHREADS) { const int row = idx >> 3, c8 = idx & 7; const int tk = t0 - 128 + row;
        u32x4 v = (u32x4){0u, 0u, 0u, 0u}; if (tk >= 0) v = *(const u32x4*)(Z + (rowbase + tk) * ZLD + ZSK + kvh * 64 + c8 * 8);
        *(LAS u32x4*)(Ks + row * 72 + c8 * 8) = v; }
#pragma unroll
    for (int g = 0; g < 4; ++g) { const int kg = w * 4 + g; unsigned pk[4];
#pragma unroll
        for (int jj = 0; jj < 8; ++jj) { const int tk = t0 - 128 + kg * 8 + jj; unsigned vb = 0u; if (tk >= 0) vb = Z[(rowbase + tk) * ZLD + ZSV + kvh * 64 + lane];
            if (jj & 1) pk[jj >> 1] |= vb << 16; else pk[jj >> 1] = vb; }
        *(LAS u32x4*)(Vt + lane * 280 + kg * 8) = (u32x4){pk[0], pk[1], pk[2], pk[3]}; }
    { unsigned zr; asm volatile("v_mov_b32 %0, 0" : "=v"(zr)); const u32x4 zv = (u32x4){zr, zr, zr, zr};
      if (tid < 128) *(LAS u32x4*)(Vt + (tid >> 1) * 280 + 256 + (tid & 1) * 8) = zv;
      if (lane < 32) *(LAS u32x4*)(Pw + (lane >> 1) * 168 + 144 + (lane & 1) * 8) = zv; }
    __syncthreads();
    const float slope = exp2f(-(float)(hq + 1)); const float sink = sinks[hq];
#pragma unroll
    for (int rt = 0; rt < 4; ++rt) {
        const int kbase = 64 * half + 16 * rt;
        const bf16x8 qa0 = qf[rt][0], qa1 = qf[rt][1];
        f32x4 sc[9];
#pragma unroll
        for (int n = 0; n < 9; ++n) { const LAS bf16_t* kb = Ks + (kbase + 16 * n + l15) * 72 + quad * 8; f32x4 a4 = (f32x4){0.f, 0.f, 0.f, 0.f};
            a4 = mfma16(qa0, *(const LAS bf16x8*)kb, a4); a4 = mfma16(qa1, *(const LAS bf16x8*)(kb + 32), a4); sc[n] = a4; }
        float mx[4] = {sink, sink, sink, sink};
#pragma unroll
        for (int n = 0; n < 9; ++n)
#pragma unroll
            for (int j = 0; j < 4; ++j) { const int qi = kbase + quad * 4 + j, kk = kbase + 16 * n + l15; const int dist = qi + 128 - kk;
                const bool valid = (dist >= 0) && (dist < 128) && (t0 - 128 + kk >= 0);
                const float lg = valid ? sc[n][j] * 0.125f - slope * (float)dist : -INFINITY; sc[n][j] = lg; mx[j] = fmaxf(mx[j], lg); }
#pragma unroll
        for (int j = 0; j < 4; ++j) { mx[j] = fmaxf(mx[j], __shfl_xor(mx[j], 1)); mx[j] = fmaxf(mx[j], __shfl_xor(mx[j], 2)); mx[j] = fmaxf(mx[j], __shfl_xor(mx[j], 4)); mx[j] = fmaxf(mx[j], __shfl_xor(mx[j], 8)); }
        float sum[4] = {0.f, 0.f, 0.f, 0.f};
#pragma unroll
        for (int n = 0; n < 9; ++n)
#pragma unroll
            for (int j = 0; j < 4; ++j) { const float p = __expf(sc[n][j] - mx[j]); sum[j] += p; Pw[(quad * 4 + j) * 168 + 16 * n + l15] = (bf16_t)hwbf(p); }
        float rden[4];
#pragma unroll
        for (int j = 0; j < 4; ++j) { sum[j] += __shfl_xor(sum[j], 1); sum[j] += __shfl_xor(sum[j], 2); sum[j] += __shfl_xor(sum[j], 4); sum[j] += __shfl_xor(sum[j], 8);
            rden[j] = __builtin_amdgcn_rcpf(sum[j] + __expf(sink - mx[j])); }
        asm volatile("s_waitcnt lgkmcnt(0)" ::: "memory");
        f32x4 o4[4];
#pragma unroll
        for (int nd = 0; nd < 4; ++nd) o4[nd] = (f32x4){0.f, 0.f, 0.f, 0.f};
#pragma unroll
        for (int ks = 0; ks < 5; ++ks) { const bf16x8 a = *(const LAS bf16x8*)(Pw + l15 * 168 + ks * 32 + quad * 8);
#pragma unroll
            for (int nd = 0; nd < 4; ++nd) o4[nd] = mfma16(a, *(const LAS bf16x8*)(Vt + (nd * 16 + l15) * 280 + kbase + ks * 32 + quad * 8), o4[nd]); }
#pragma unroll
        for (int nd = 0; nd < 4; ++nd)
#pragma unroll
            for (int j = 0; j < 4; ++j) Z[(rowbase + t0 + kbase + quad * 4 + j) * ZLD + ZSQ + hq * 64 + nd * 16 + l15] = (bf16_t)hwbf(o4[nd][j] * rden[j]);
        asm volatile("s_waitcnt lgkmcnt(0)" ::: "memory");
    }
    __syncthreads();
}


#define XB_TMO      128
#define XB_XCNT(j)  (256  + 64 * (j))
#define XB_XSUB(j)  (1280 + 64 * (j))
#define XB_XGEN(j)  (2304 + 64 * (j))
#define XB_TOP      3328
#define XB_TOPGEN   3392
#define XCD_BAR_WORDS 3456
#define XB_SPIN_CAP (1u << 18)
__device__ __forceinline__ unsigned xb_ld(unsigned* p)              { return __hip_atomic_load(p, __ATOMIC_RELAXED, __HIP_MEMORY_SCOPE_AGENT); }
__device__ __forceinline__ unsigned xb_add(unsigned* p, unsigned v) { return __hip_atomic_fetch_add(p, v, __ATOMIC_RELAXED, __HIP_MEMORY_SCOPE_AGENT); }
__device__ __forceinline__ unsigned xb_xcc_id() { return (unsigned)__builtin_amdgcn_s_getreg((3 << 11) | 20) & 0xFu; }
#define XB_SPIN(cond, bar) do { unsigned _sp = 0; while (cond) { __builtin_amdgcn_s_sleep(1); \
    if ((++_sp & 255u) == 0u) { if (xb_ld(&(bar)[XB_TMO])) break; if (_sp > XB_SPIN_CAP) { atomicAdd(&(bar)[XB_TMO], 1u); break; } } } } while (0)
struct XcdBarrier { unsigned* bar; unsigned x; volatile LAS unsigned* st; };
__device__ __forceinline__ XcdBarrier xcd_barrier_post(unsigned* bar, volatile LAS unsigned* st) {
    XcdBarrier b; b.bar = bar; b.x = xb_xcc_id(); b.st = st;
    if (threadIdx.x == 0) (void)xb_add(&bar[XB_XCNT(b.x)], 1u);
    return b;
}
__device__ __forceinline__ void xcd_barrier_complete(unsigned* bar, unsigned x, unsigned& nloc, unsigned& nx) {
    const unsigned G = gridDim.x * gridDim.y * gridDim.z;
    unsigned sum, cnt, mine, sp = 0u;
    for (;;) {
        sum = 0u; cnt = 0u; mine = 0u;
#pragma unroll
        for (unsigned j = 0; j < 16; ++j) { const unsigned c = xb_ld(&bar[XB_XCNT(j)]); sum += c; cnt += (c > 0u) ? 1u : 0u; mine = (j == x) ? c : mine; }
        if (sum == G) break;
        __builtin_amdgcn_s_sleep(1);
        if ((++sp & 255u) == 0u) { if (xb_ld(&bar[XB_TMO])) break; if (sp > XB_SPIN_CAP) { atomicAdd(&bar[XB_TMO], 1u); break; } }
    }
    nloc = mine > 0u ? mine : 1u; nx = cnt > 0u ? cnt : 1u;
}
__device__ __forceinline__ void xcd_barrier(const XcdBarrier& b) {
    asm volatile("s_waitcnt vmcnt(0)" ::: "memory");
    __syncthreads();
    if (threadIdx.x == 0) {
        unsigned* bar = b.bar; asm volatile("" : "+s"(bar));
        __builtin_amdgcn_s_waitcnt(0);
        unsigned nloc = b.st[0], nx = b.st[1];
        if (nloc == 0u) { xcd_barrier_complete(bar, b.x, nloc, nx); b.st[0] = nloc; b.st[1] = nx; }
        const unsigned old = xb_add(&bar[XB_XSUB(b.x)], 1u);
        const unsigned gen = old / nloc;
        if (old + 1u == (gen + 1u) * nloc) {
            __builtin_amdgcn_fence(__ATOMIC_RELEASE, "agent");
            asm volatile("s_waitcnt vmcnt(0)" ::: "memory");
            const unsigned og = xb_add(&bar[XB_TOP], 1u);
            const unsigned tg = og / nx;
            if (og + 1u == (tg + 1u) * nx) xb_add(&bar[XB_TOPGEN], 1u);
            else XB_SPIN(xb_ld(&bar[XB_TOPGEN]) == tg, bar);
            __builtin_amdgcn_fence(__ATOMIC_ACQUIRE, "agent");
            xb_add(&bar[XB_XGEN(b.x)], 1u);
            asm volatile("s_waitcnt vmcnt(0)" ::: "memory");
        } else {
            XB_SPIN(xb_ld(&bar[XB_XGEN(b.x)]) == gen, bar);
            __builtin_amdgcn_fence(__ATOMIC_ACQUIRE, "agent");
            asm volatile("s_waitcnt vmcnt(0)" ::: "memory");
        }
    }
    __syncthreads();
}

struct Args { const float* in[17]; float* out; unsigned char* ws; };

__global__ void __launch_bounds__(NTHREADS, 2) mega_fwd(Args args) {
    extern __shared__ __attribute__((aligned(16))) unsigned char lds_raw[];
    LAS unsigned char* lds = (LAS unsigned char*)lds_raw;
    cg::grid_group grid = cg::this_grid();
    const int G = gridDim.x, blk = blockIdx.x, NGW = G * 8;
#define FRESH_IDS() const int tid = fresh_tid(), lane = tid & 63, wave = __builtin_amdgcn_readfirstlane(tid >> 6), gw = blk * 8 + wave; (void)lane; (void)gw
    const float* x = args.in[0]; float* out = args.out;
    bf16_t* Wb = (bf16_t*)(args.ws + WS_W);
    bf16_t* U = (bf16_t*)(args.ws + WS_U);
    bf16_t* Z = (bf16_t*)(args.ws + WS_BIG);
    bf16_t* MRG = (bf16_t*)(args.ws + WS_BIG + 288 * MiB);
    float* SSQ = (float*)(args.ws + WS_SSQ);
    bf16_t* ACT = (bf16_t*)(args.ws + WS_BIG);
    float* PRE = (float*)(args.ws + WS_BIG + 176 * MiB);

    volatile LAS unsigned* MISC = (volatile LAS unsigned*)(lds + LDS_BYTES - 64);
    unsigned* barw = (unsigned*)(args.ws + WS_BAR);
    { FRESH_IDS(); if (tid < 16) MISC[tid] = 0u;
    }
    __syncthreads();
    const XcdBarrier xbar = xcd_barrier_post(barw, MISC + 8);
#define GRID_BAR() xcd_barrier(xbar)
    {
        FRESH_IDS();
        LAS float* scr = (LAS float*)(lds + wave * 16384);
        constexpr int I_A = 16 * 64, I_B = 16 * 72, I_G = 16 * 96, I_P = 8 * 32, I_O = 16 * 32, I_UP = 16 * 176, I_DN = 44 * 32;
        constexpr int I_LAYER = I_A + I_B + I_G + 3 * I_P + I_O + I_UP + I_DN;
        for (int it = gw; it < 2 * I_LAYER; it += NGW) {
            const int l = it / I_LAYER; int r = it - l * I_LAYER;
            bf16_t* WL = Wb + (size_t)l * LAYER_W;
            const float* w_in = args.in[2] + (size_t)l * DM * DIN;
            if (r < I_A) { transpose_item(w_in, DIN, 2048, WL + OW_IN, DM, 0, scr, r, lane, args.in[1] + l * DM); continue; } r -= I_A;
            if (r < I_B) { transpose_item(w_in + 2064, DIN, 2304, WL + OW_IN, DM, 2048, scr, r, lane, args.in[1] + l * DM); continue; } r -= I_B;
            if (r < I_G) { transpose_item(w_in + 4368, DIN, 3072, WL + OW_G, DM, 0, scr, r, lane, args.in[1] + l * DM); continue; } r -= I_G;
            if (r < I_P) { transpose_item(args.in[8] + (size_t)l * 512 * DM, DM, DM, WL + OW_GLA, 512, 0, scr, r, lane); continue; } r -= I_P;
            if (r < I_P) { transpose_item(args.in[9] + (size_t)l * 512 * DM, DM, DM, WL + OW_CONV, 512, 0, scr, r, lane); continue; } r -= I_P;
            if (r < I_P) { transpose_item(args.in[10] + (size_t)l * 512 * DM, DM, DM, WL + OW_SWA, 512, 0, scr, r, lane); continue; } r -= I_P;
            if (r < I_O) { transpose_item(args.in[11] + (size_t)l * DM * DM, DM, DM, WL + OW_O, DM, 0, scr, r, lane); continue; } r -= I_O;
            if (r < I_UP) { transpose_item<true>(args.in[13] + (size_t)l * DM * DFF2, DFF2, DFF2, WL + OW_UP, DM, 0, scr, r, lane, args.in[12] + l * DM); continue; } r -= I_UP;
            transpose_item(args.in[15] + (size_t)l * DFF * DM, DM, DM, WL + OW_DN, DFF, 0, scr, r, lane);
        }
        for (int idx = blk * NTHREADS + tid; idx < 2 * 256 * DM; idx += G * NTHREADS) {
            const int l = idx / (256 * DM), rem = idx - l * 256 * DM, row = rem >> 10, k = rem & 1023;
            const float v = row < 16 ? args.in[2][(size_t)l * DM * DIN + (size_t)k * DIN + 2048 + row] * args.in[1][l * DM + k] : 0.f;
            Wb[(size_t)l * LAYER_W + OW_IN + (size_t)(4352 + row) * DM + k] = (bf16_t)f2bf(v);
        }
        for (int m = gw; m < T; m += 4 * NGW) {
            f32x4 v[4][4]; float sq[4];
#pragma unroll
            for (int h4 = 0; h4 < 4; ++h4) { const int mm = m + h4 * NGW; const f32x4* xr = (const f32x4*)(x + (size_t)(mm < T ? mm : m) * DM) + lane;
#pragma unroll
                for (int j = 0; j < 4; ++j) v[h4][j] = xr[64 * j]; }
#pragma unroll
            for (int h4 = 0; h4 < 4; ++h4) { float q = 0.f;
#pragma unroll
                for (int j = 0; j < 4; ++j) q += (v[h4][j].x * v[h4][j].x + v[h4][j].y * v[h4][j].y) + (v[h4][j].z * v[h4][j].z + v[h4][j].w * v[h4][j].w);
                sq[h4] = q; }
#pragma unroll
            for (int o = 1; o < 64; o <<= 1) {
#pragma unroll
                for (int h4 = 0; h4 < 4; ++h4) sq[h4] += __shfl_xor(sq[h4], o); }
#pragma unroll
            for (int h4 = 0; h4 < 4; ++h4) { const int mm = m + h4 * NGW; if (mm < T) {
                unsigned long long* o8 = (unsigned long long*)(U + (size_t)mm * DM) + lane;
#pragma unroll
                for (int j = 0; j < 4; ++j) o8[64 * j] = (unsigned long long)pk2(v[h4][j].x, v[h4][j].y) | ((unsigned long long)pk2(v[h4][j].z, v[h4][j].w) << 32);
                if (lane < 4) *(f32x4*)(SSQ + ((size_t)lane * T + mm) * 4) = (f32x4){lane == 0 ? sq[h4] : 0.f, 0.f, 0.f, 0.f}; } }
        }
    }
    GRID_BAR();
    if (G == 0x7fffffff) grid.sync();

    for (int l = 0; l < 2; ++l) {
        const bf16_t* WL = Wb + (size_t)l * LAYER_W;
        {
            pg8::Gemm g{U, U, U, WL + OW_IN, WL + OW_IN, WL + OW_IN};
            pg8::StaticOrder<1, ZLD> S; S.init(G, blk);
            pg8::EpiBf16<0> E{Z, ZLD, SSQ};
            if (PHM & 16) pg8::gemm_phase<pg8::EpiBf16<0>, pg8::StaticOrder<1, ZLD>, 1, DM, DM, DM>(lds, g, S, E);
        }
        GRID_BAR();
        {
            float* Sbuf = (float*)(args.ws + WS_SBUF); float* Btot = (float*)(args.ws + WS_BTOT);
            if (PHM & 1) for (int u = blk; u < 256; u += G) gla_segment<false>(lds, Z, args.in[3] + (size_t)l * 16 * 512, args.in[4] + (size_t)l * 512, args.in[5] + (size_t)l * 512, u, Sbuf, Btot);
            for (int u = blk; u < NB * 32 * 2; u += G) { const int kvh = u & 1, qb = (u >> 1) & 31, b = u >> 6; if (PHM & 2) swa_unit(lds, Z, args.in[7] + l * 8, b, qb, kvh); }
        }
        GRID_BAR();
        {
            float* Sbuf = (float*)(args.ws + WS_SBUF); float* Btot = (float*)(args.ws + WS_BTOT);
            if (PHM & 1) for (int u = blk; u < 256; u += G) gla_segment<true>(lds, Z, args.in[3] + (size_t)l * 16 * 512, args.in[4] + (size_t)l * 512, args.in[5] + (size_t)l * 512, u, Sbuf, Btot);
            FRESH_IDS();
            const float* cw = args.in[6] + (size_t)l * 3 * 512;
            if (PHM & 4) for (int it = blk * NTHREADS + tid; it < (T / 4) * 64; it += G * NTHREADS) {
                const int tg = it >> 6, c8 = it & 63, t0 = tg * 4; const bool has_prev = (t0 & (SEQ - 1)) != 0;
                bf16_t* zp = Z + (size_t)t0 * ZLD + c8 * 8;
                const u32x4 z4 = (u32x4){0u, 0u, 0u, 0u};
                u32x4 xm2 = z4, cm2 = z4, xm1 = z4, cm1 = z4, xr[4], cr[4], br[4];
                if (has_prev) { xm2 = *(const u32x4*)(zp - 2 * ZLD + ZCX); cm2 = *(const u32x4*)(zp - 2 * ZLD + ZCC); xm1 = *(const u32x4*)(zp - ZLD + ZCX); cm1 = *(const u32x4*)(zp - ZLD + ZCC); }
#pragma unroll
                for (int q = 0; q < 4; ++q) { xr[q] = *(const u32x4*)(zp + (size_t)q * ZLD + ZCX); cr[q] = *(const u32x4*)(zp + (size_t)q * ZLD + ZCC); br[q] = *(const u32x4*)(zp + (size_t)q * ZLD + ZCB); }
                float w0[8], w1[8], w2[8], p2[8], p1[8];
#pragma unroll
                for (int e = 0; e < 8; ++e) { w0[e] = cw[c8 * 8 + e]; w1[e] = cw[512 + c8 * 8 + e]; w2[e] = cw[1024 + c8 * 8 + e]; }
#pragma unroll
                for (int e = 0; e < 4; ++e) { p2[2 * e] = bflo(xm2[e]) * bflo(cm2[e]); p2[2 * e + 1] = bfhi(xm2[e]) * bfhi(cm2[e]); p1[2 * e] = bflo(xm1[e]) * bflo(cm1[e]); p1[2 * e + 1] = bfhi(xm1[e]) * bfhi(cm1[e]); }
#pragma unroll
                for (int q = 0; q < 4; ++q) { float p0[8]; unsigned res[4];
#pragma unroll
                    for (int e = 0; e < 4; ++e) { p0[2 * e] = bflo(xr[q][e]) * bflo(cr[q][e]); p0[2 * e + 1] = bfhi(xr[q][e]) * bfhi(cr[q][e]); }
#pragma unroll
                    for (int e = 0; e < 4; ++e) {
                        const float lo = bflo(br[q][e]) * (w0[2 * e] * p2[2 * e] + w1[2 * e] * p1[2 * e] + w2[2 * e] * p0[2 * e]);
                        const float hi = bfhi(br[q][e]) * (w0[2 * e + 1] * p2[2 * e + 1] + w1[2 * e + 1] * p1[2 * e + 1] + w2[2 * e + 1] * p0[2 * e + 1]);
                        res[e] = pk2(lo, hi); }
                    *(u32x4*)(zp + (size_t)q * ZLD + ZCB) = (u32x4){res[0], res[1], res[2], res[3]};
#pragma unroll
                    for (int e = 0; e < 8; ++e) { p2[e] = p1[e]; p1[e] = p0[e]; } }
            }
        }
        GRID_BAR();
        {
            pg8::Gemm g{U, U, U, WL + OW_G, WL + OW_G, WL + OW_G};
            pg8::StaticOrder<1, 3072> S; S.init(G, blk);
            pg8::EpiBf16<1> E{Z, ZLD, SSQ};
            if (PHM & 32) pg8::gemm_phase<pg8::EpiBf16<1>, pg8::StaticOrder<1, 3072>, 1, DM, DM, DM>(lds, g, S, E);
        }
        GRID_BAR();
        {
            pg8::Gemm g{Z + ZR, Z + ZCB, Z + ZSQ, WL + OW_GLA, WL + OW_CONV, WL + OW_SWA};
            pg8::StaticOrder<3, DM> S; S.init(G, blk);
            pg8::EpiMerge E{Z, MRG, DM};
            if (PHM & 64) pg8::gemm_phase<pg8::EpiMerge, pg8::StaticOrder<3, DM>, 3, 512, ZLD, 512>(lds, g, S, E);
        }
        GRID_BAR();
        {
            pg8::Gemm g{MRG, MRG, MRG, WL + OW_O, WL + OW_O, WL + OW_O};
            pg8::StaticOrder<1, DM> S; S.init(G, blk);
            pg8::EpiResid E{(const float*)nullptr, U, (float*)nullptr, DM, U, SSQ};
            if (PHM & 128) pg8::gemm_phase<pg8::EpiResid, pg8::StaticOrder<1, DM>, 1, DM, DM, DM>(lds, g, S, E);
        }
        GRID_BAR();
        {
            pg8::Gemm g{U, U, U, WL + OW_UP, WL + OW_UP, WL + OW_UP};
            pg8::StaticOrder<1, DFF2> S; S.init(G, blk);
            pg8::EpiAct E{ACT, PRE, args.in[14] + (size_t)l * 3 * DFF2, lds + 131072, SSQ};
            if (PHM & 16) pg8::gemm_phase<pg8::EpiAct, pg8::StaticOrder<1, DFF2>, 1, DM, DM, DM>(lds, g, S, E);
        }
        GRID_BAR();
        {
            pg8::Gemm g{ACT, ACT, ACT, WL + OW_DN, WL + OW_DN, WL + OW_DN};
            pg8::StaticOrder<1, DM> S; S.init(G, blk);
            {
                FRESH_IDS();
                const float* fw = args.in[14] + (size_t)l * 3 * DFF2;
                pg8::Unit fu;
                for (int i = 0; S.next(i, fu); ++i) {
                    const int pm = fu.pm; const bool first = (pm & 15) == 0;
                    const float* P0 = PRE + (size_t)pm * 4 * DFF2; const float* Pp = PRE + (size_t)(pm - 1) * 4 * DFF2;
                    float fx0[6][2], fx1[6][2], fm2[6][2], fm1[6][2], fw0[6][2], fw1[6][2], fw2[6][2];
#pragma unroll
                    for (int k = 0; k < 6; ++k) { const int c = tid + k * NTHREADS;
#pragma unroll
                        for (int hbj = 0; hbj < 2; ++hbj) { const int cc = (c < DFF ? c : tid) + hbj * DFF;
                            fx0[k][hbj] = P0[cc]; fx1[k][hbj] = P0[DFF2 + cc]; fm2[k][hbj] = first ? 0.f : Pp[2 * DFF2 + cc]; fm1[k][hbj] = first ? 0.f : Pp[3 * DFF2 + cc];
                            fw0[k][hbj] = fw[cc]; fw1[k][hbj] = fw[DFF2 + cc]; fw2[k][hbj] = fw[2 * DFF2 + cc]; } }
#pragma unroll
                    for (int k = 0; k < 6; ++k) { const int c = tid + k * NTHREADS;
                        if (c < DFF) {
                            const float ra0 = fw0[k][0] * fm2[k][0] + fw1[k][0] * fm1[k][0] + fw2[k][0] * fx0[k][0], ra1 = fw0[k][0] * fm1[k][0] + fw1[k][0] * fx0[k][0] + fw2[k][0] * fx1[k][0];
                            const float rb0 = fw0[k][1] * fm2[k][1] + fw1[k][1] * fm1[k][1] + fw2[k][1] * fx0[k][1], rb1 = fw0[k][1] * fm1[k][1] + fw1[k][1] * fx0[k][1] + fw2[k][1] * fx1[k][1];
                            ACT[(size_t)(pm * 256) * DFF + c] = (bf16_t)f2bf(siluf_(ra0) * rb0);
                            ACT[(size_t)(pm * 256 + 1) * DFF + c] = (bf16_t)f2bf(siluf_(ra1) * rb1); } }
                }
                __threadfence();
                asm volatile("s_waitcnt vmcnt(0)" ::: "memory");
                __syncthreads();
                __builtin_amdgcn_fence(__ATOMIC_ACQUIRE, "agent");
            }
            pg8::EpiResid E{(const float*)nullptr, U, (float*)nullptr, DM, U, SSQ};
            if (PHM & 128) pg8::gemm_phase<pg8::EpiResid, pg8::StaticOrder<1, DM>, 1, DFF, DFF, DFF>(lds, g, S, E);
        }
        GRID_BAR();
    }
    { FRESH_IDS();
      const f32x4* gr = (const f32x4*)args.in[16] + lane;
      for (int m = gw; m < T; m += 4 * NGW) {
          u32x2 v[4][4]; f32x4 pq[4][4];
#pragma unroll
          for (int h4 = 0; h4 < 4; ++h4) { const int mm = (m + h4 * NGW) < T ? (m + h4 * NGW) : m; const u32x2* hr = (const u32x2*)(U + (size_t)mm * DM) + lane;
#pragma unroll
              for (int j = 0; j < 4; ++j) { v[h4][j] = hr[64 * j]; pq[h4][j] = *(const f32x4*)(SSQ + ((size_t)j * T + mm) * 4); } }
#pragma unroll
          for (int h4 = 0; h4 < 4; ++h4) { const int mm = m + h4 * NGW; if (mm < T) {
              float sq = 0.f;
#pragma unroll
              for (int j = 0; j < 4; ++j) sq += (pq[h4][j].x + pq[h4][j].y) + (pq[h4][j].z + pq[h4][j].w);
              const float rstd = __builtin_amdgcn_rsqf(sq * (1.f / DM) + EPS); f32x4* xw = (f32x4*)(out + (size_t)mm * DM) + lane;
#pragma unroll
              for (int j = 0; j < 4; ++j) { const f32x4 hv = (f32x4){bflo(v[h4][j].x), bfhi(v[h4][j].x), bflo(v[h4][j].y), bfhi(v[h4][j].y)}; xw[64 * j] = hv * rstd * gr[64 * j]; } } }
      }
    }
}

extern "C" void kernel_launch(void* const* d_in, const int* in_sizes, int n_in, void* d_out, int out_size, void* d_ws, size_t ws_size, hipStream_t stream) {
    static int grid_blocks = 0;
    if (grid_blocks == 0) {
        if (n_in != 17 || out_size != T * DM || ws_size < WS_END) { fprintf(stderr, "kernel_launch: unexpected shapes (n_in %d out %d ws %zu)\n", n_in, out_size, ws_size); grid_blocks = -1; return; }
        int dev = 0, cus = 0, per_cu = 0;
        hipGetDevice(&dev);
        hipDeviceGetAttribute(&cus, hipDeviceAttributeMultiprocessorCount, dev);
        if (hipFuncSetAttribute((const void*)mega_fwd, hipFuncAttributeMaxDynamicSharedMemorySize, LDS_BYTES) != hipSuccess) { fprintf(stderr, "kernel_launch: hipFuncSetAttribute failed\n"); grid_blocks = -1; return; }
        if (hipOccupancyMaxActiveBlocksPerMultiprocessor(&per_cu, (const void*)mega_fwd, NTHREADS, LDS_BYTES) != hipSuccess || per_cu < 1) { fprintf(stderr, "kernel_launch: occupancy query says %d\n", per_cu); per_cu = 1; }
        (void)hipGetLastError();
        grid_blocks = cus * (per_cu > 1 ? 1 : per_cu);
        fprintf(stderr, "kernel_launch: grid %d (cus %d, per_cu %d), ws %zu\n", grid_blocks, cus, per_cu, ws_size);
    }
    if (grid_blocks < 0) return;
    Args a{};
    for (int i = 0; i < 17; ++i) a.in[i] = (const float*)d_in[i];
    a.out = (float*)d_out; a.ws = (unsigned char*)d_ws;
    void* kargs[] = {&a};
    if (hipMemsetAsync((unsigned char*)d_ws + WS_BAR, 0, XCD_BAR_WORDS * 4, stream) != hipSuccess) { fprintf(stderr, "kernel_launch: memset of the barrier words failed\n"); return; }
    hipError_t e = hipLaunchCooperativeKernel((const void*)mega_fwd, dim3(grid_blocks), dim3(NTHREADS), kargs, LDS_BYTES, stream);
    if (e != hipSuccess) fprintf(stderr, "kernel_launch: cooperative launch failed: %s (grid %d)\n", hipGetErrorString(e), grid_blocks);
}
```

```cpp
#include <hip/hip_runtime.h>
#include <hip/hip_cooperative_groups.h>
#include <cstdio>
#include <cstdint>
#include <cmath>
namespace cg = cooperative_groups;

#define LAS __attribute__((address_space(3)))
typedef unsigned short bf16_t;
typedef short bf16x8 __attribute__((ext_vector_type(8)));
typedef float f32x4 __attribute__((ext_vector_type(4)));
typedef float f32x2 __attribute__((ext_vector_type(2)));
typedef unsigned u32x4 __attribute__((ext_vector_type(4)));
typedef unsigned u32x2 __attribute__((ext_vector_type(2)));

constexpr int NB = 8, SEQ = 4096, T = NB * SEQ, DM = 1024, DIN = 7440, DFF = 2816, DFF2 = 5632;
constexpr int ZLD = 4608;
constexpr int ZQ = 0, ZK = 512, ZV = 1024, ZR = 1536, ZCX = 2048, ZCB = 2560, ZCC = 3072, ZSQ = 3584, ZSK = 4096, ZSV = 4224, ZGA = 4352;
constexpr float EPS = 1e-6f;
constexpr size_t OW_IN = 0, OW_G = 4718592, OW_GLA = 7864320, OW_CONV = 8388608, OW_SWA = 8912896, OW_O = 9437184, OW_UP = 10485760, OW_DN = 16252928, LAYER_W = 19136512;
constexpr size_t MiB = 1u << 20;
constexpr size_t WS_W = 0, WS_BTOT = 76 * MiB, WS_BAR = 77 * MiB, WS_SSQ = 78 * MiB, WS_U = 80 * MiB, WS_BIG = 144 * MiB, WS_SBUF = 496 * MiB, WS_END = 512 * MiB;
static_assert(2 * LAYER_W * 2 <= WS_BTOT, "weights fit");
constexpr int LDS_BYTES = 147456;
constexpr int NTHREADS = 512;
#ifndef PHM
#define PHM 0xffff
#endif

__device__ __forceinline__ unsigned f2bf(float f) { unsigned u = __builtin_bit_cast(unsigned, f); return (u + 0x7fffu + ((u >> 16) & 1u)) >> 16; }
__device__ __forceinline__ unsigned pk2(float lo, float hi) { return f2bf(lo) | (f2bf(hi) << 16); }
__device__ __forceinline__ float bf2f(bf16_t h) { return __builtin_bit_cast(float, (unsigned)h << 16); }
__device__ __forceinline__ float bflo(unsigned w) { return __builtin_bit_cast(float, w << 16); }
__device__ __forceinline__ float bfhi(unsigned w) { return __builtin_bit_cast(float, w & 0xffff0000u); }
__device__ __forceinline__ unsigned cvt_pk_bf16(float lo, float hi) { unsigned r; asm volatile("s_nop 1\n\tv_cvt_pk_bf16_f32 %0, %1, %2" : "=v"(r) : "v"(lo), "v"(hi)); return r; }
__device__ __forceinline__ unsigned hwbf(float f) { return cvt_pk_bf16(f, 0.f) & 0xffffu; }
__device__ __forceinline__ float wave_sum(float v) {
#pragma unroll
    for (int o = 1; o < 64; o <<= 1) v += __shfl_xor(v, o);
    return v;
}
__device__ __forceinline__ float sigmoidf_(float x) { return __builtin_amdgcn_rcpf(1.0f + __expf(-x)); }
__device__ __forceinline__ float siluf_(float x) { return x * __builtin_amdgcn_rcpf(1.0f + __expf(-x)); }
#define LDS_WAIT() asm volatile("s_waitcnt lgkmcnt(0)" ::: "memory")
__device__ __forceinline__ int fresh_tid() { int t = threadIdx.x; asm volatile("" : "+v"(t)); return t; }

namespace pg8 {
constexpr int BM = 256, BK = 64, HALF = 128, HTB = HALF * BK * 2, STAGE_BYTES = 8 * HTB, NXCD = 8, WGM = 8;
__host__ __device__ __forceinline__ int lds_byte(int r, int c) { const int st = (r >> 4) * 2 + (c >> 5), rr = r & 15, cc = c & 31, ob = rr * 64 + cc * 2; return st * 1024 + (ob ^ (((ob >> 9) & 1) << 5)); }
__host__ __device__ __forceinline__ void stage_rc(int b, int& R, int& C) { const int st = b / 1024, sb = b % 1024, swz = sb ^ (((sb >> 9) & 1) << 5); R = (st >> 1) * 16 + swz / 64; C = (st & 1) * 32 + (swz % 64) / 2; }
__host__ __device__ __forceinline__ int perm32(int rho) { const int n = rho >> 4, i = rho & 15; return 8 * (i >> 2) + 4 * n + (i & 3); }

struct Unit { int pm, pn, seg; };
struct Gemm { const bf16_t* A0; const bf16_t* A1; const bf16_t* A2; const bf16_t* B0; const bf16_t* B1; const bf16_t* B2; };

template <int NSEG, int N_> struct StaticOrder {
    static constexpr int nM = T / BM, nN = N_ / BM, nwg = nM * nN;
    int G, c;
    __device__ __forceinline__ void init(int G_, int c_) { G = G_; c = c_; }
    __device__ __forceinline__ bool next(int i, Unit& u) const {
        const int ti = (NSEG == 1) ? i : i / NSEG; u.seg = (NSEG == 1) ? 0 : i - ti * NSEG;
        const long L = (long)ti * G + c; if (L >= nwg) return false;
        int wgid = (int)L; { const int q = nwg / NXCD, r = nwg % NXCD, xcd = wgid % NXCD, off = wgid / NXCD; wgid = (xcd < r ? xcd * (q + 1) : r * (q + 1) + (xcd - r) * q) + off; }
        const int nig = WGM * nN, gid = wgid / nig, fm = gid * WGM, gsz = (nM - fm) < WGM ? (nM - fm) : WGM;
        u.pm = fm + ((wgid % nig) % gsz); u.pn = (wgid % nig) / gsz; return true;
    }
};


__device__ __forceinline__ void scale_rows(f32x4 (&acc)[2][2][4][2], const float* ssq, const Unit& u, int wr, int fr, int fq) {
    f32x4 p[2][4];
#pragma unroll
    for (int ai = 0; ai < 2; ++ai)
#pragma unroll
        for (int m = 0; m < 4; ++m) { const size_t r = (size_t)(u.pm * BM + ai * HALF + wr * 64 + m * 16 + fr); p[ai][m] = *(const f32x4*)(ssq + ((size_t)fq * T + r) * 4); }
#pragma unroll
    for (int ai = 0; ai < 2; ++ai)
#pragma unroll
        for (int m = 0; m < 4; ++m) { float sq = (p[ai][m].x + p[ai][m].y) + (p[ai][m].z + p[ai][m].w);
            sq += __shfl_xor(sq, 16); sq += __shfl_xor(sq, 32);
            const float rs = __builtin_amdgcn_rsqf(sq * (1.0f / DM) + EPS);
#pragma unroll
            for (int bj = 0; bj < 2; ++bj)
#pragma unroll
                for (int n = 0; n < 2; ++n) acc[ai][bj][m][n] = acc[ai][bj][m][n] * rs; }
}

template <int MODE  > struct EpiBf16 {
    static constexpr bool PERM = true;
    bf16_t* O; int ldc; const float* ssq;
    __device__ __forceinline__ bool keep(const Unit&) const { return false; }
    __device__ __forceinline__ static int gate_zcol(int tile) {
        return tile < 4 ? tile * 256 : tile < 6 ? 1024 + (tile - 4) * 256 : tile < 8 ? ZCX + (tile - 6) * 256 : tile < 10 ? ZCC + (tile - 8) * 256 : tile == 10 ? ZSK : ZGA;
    }
    __device__ __forceinline__ void operator()(f32x4 (&acc)[2][2][4][2], const Unit& u, int wr, int wc, int fr, int fq) const {
        scale_rows(acc, ssq, u, wr, fr, fq);
        const int row0 = u.pm * BM + wr * 64 + fr;
        const int colt = (MODE == 1) ? gate_zcol(u.pn) : u.pn * BM;
        const int col0 = colt + wc * 32 + 8 * fq;
#pragma unroll
        for (int ai = 0; ai < 2; ++ai)
#pragma unroll
            for (int m = 0; m < 4; ++m) { bf16_t* rowp = O + (size_t)(row0 + ai * HALF + m * 16) * ldc + col0;
#pragma unroll
                for (int bj = 0; bj < 2; ++bj) { f32x4 v0 = acc[ai][bj][m][0], v1 = acc[ai][bj][m][1];
                    if (MODE == 1) {
                        unsigned g0 = 0u, g1 = 0u;
#pragma unroll
                        for (int e = 0; e < 4; ++e) { g0 = __builtin_amdgcn_cvt_pk_u8_f32(fmaxf(floorf(255.f * sigmoidf_(v0[e]) + 0.5f), 1.f), e, g0);
                                                      g1 = __builtin_amdgcn_cvt_pk_u8_f32(fmaxf(floorf(255.f * sigmoidf_(v1[e]) + 0.5f), 1.f), e, g1); }
                        *(u32x2*)((unsigned char*)O + ((size_t)(row0 + ai * HALF + m * 16) * ldc + colt) * 2 + bj * HALF + wc * 32 + 8 * fq) = (u32x2){g0, g1};
                    } else {
                    if (u.pn * BM + bj * HALF + wc * 32 + 8 * fq < ZGA + 16) {
                    u32x4 w; w.x = cvt_pk_bf16(v0[0], v0[1]); w.y = cvt_pk_bf16(v0[2], v0[3]); w.z = cvt_pk_bf16(v1[0], v1[1]); w.w = cvt_pk_bf16(v1[2], v1[3]);
                    *(u32x4*)(rowp + bj * HALF) = w; } } } }
    }
};

struct EpiMerge {
    static constexpr bool PERM = true;
    const bf16_t* Zg; bf16_t* O; int ldc;
    __device__ __forceinline__ bool keep(const Unit& u) const { return u.seg != 2; }
    __device__ __forceinline__ void operator()(f32x4 (&acc)[2][2][4][2], const Unit& u, int wr, int wc, int fr, int fq) const {
        const int row0 = u.pm * BM + wr * 64 + fr;
        const int seg = u.seg;
        const int gnum = EpiBf16<1>::gate_zcol(4 * seg + u.pn) * 2 + wc * 32 + 8 * fq;
        const int gden = EpiBf16<1>::gate_zcol(4 * (seg < 2 ? seg + 1 : 2) + u.pn) * 2 + wc * 32 + 8 * fq;
        const int col0 = u.pn * BM + wc * 32 + 8 * fq;
        const unsigned char* Zb = (const unsigned char*)Zg;
        u32x2 gnv[2][4][2], gdv[2][4][2];
#pragma unroll
        for (int ai = 0; ai < 2; ++ai)
#pragma unroll
            for (int m = 0; m < 4; ++m) { const size_t r = (size_t)(row0 + ai * HALF + m * 16);
#pragma unroll
                for (int bj = 0; bj < 2; ++bj) { gnv[ai][m][bj] = *(const u32x2*)(Zb + r * (ZLD * 2) + gnum + bj * HALF);
                    gdv[ai][m][bj] = (seg < 2) ? *(const u32x2*)(Zb + r * (ZLD * 2) + gden + bj * HALF) : (u32x2){0u, 0u}; } }
#pragma unroll
        for (int ai = 0; ai < 2; ++ai) {
#pragma unroll
            for (int m = 0; m < 4; ++m) { const size_t r = (size_t)(row0 + ai * HALF + m * 16);
#pragma unroll
                for (int bj = 0; bj < 2; ++bj) {
                    const u32x2 gn = gnv[ai][m][bj], gd = gdv[ai][m][bj];
                    float f[8];
#pragma unroll
                    for (int e = 0; e < 4; ++e) { f[e] = (float)((gn.x >> (8 * e)) & 0xffu); f[4 + e] = (float)((gn.y >> (8 * e)) & 0xffu); }
                    if (seg < 2) {
#pragma unroll
                        for (int e = 0; e < 4; ++e) { f[e] = f[e] * __builtin_amdgcn_rcpf((float)((gd.x >> (8 * e)) & 0xffu)); f[4 + e] = f[4 + e] * __builtin_amdgcn_rcpf((float)((gd.y >> (8 * e)) & 0xffu)); }
                    } else {
#pragma unroll
                        for (int e = 0; e < 8; ++e) f[e] = f[e] * (1.0f / 255.0f);
                    }
                    f32x4 v0 = acc[ai][bj][m][0], v1 = acc[ai][bj][m][1];
#pragma unroll
                    for (int e = 0; e < 4; ++e) { v0[e] *= f[e]; v1[e] *= f[4 + e]; }
                    acc[ai][bj][m][0] = v0; acc[ai][bj][m][1] = v1;
                    if (seg == 2) {
                        u32x4 w; w.x = cvt_pk_bf16(v0[0], v0[1]); w.y = cvt_pk_bf16(v0[2], v0[3]); w.z = cvt_pk_bf16(v1[0], v1[1]); w.w = cvt_pk_bf16(v1[2], v1[3]);
                        *(u32x4*)(O + r * ldc + col0 + bj * HALF) = w;
                    }
                } }
        }
    }
};

#define DPPF(v, ctrl) __builtin_bit_cast(float, __builtin_amdgcn_update_dpp(0, __builtin_bit_cast(int, (v)), (ctrl), 0xf, 0xf, true))
struct EpiAct {
    static constexpr bool PERM = true;
    bf16_t* ACT; float* PRE; const float* fw; LAS unsigned char* xch; const float* ssq;
    __device__ __forceinline__ bool keep(const Unit&) const { return false; }
    __device__ __forceinline__ void operator()(f32x4 (&acc)[2][2][4][2], const Unit& u, int wr, int wc, int fr, int fq) const {
        LAS float* X = (LAS float*)xch;
        const int chb = u.pn * 128 + wc * 32 + 8 * fq;
        f32x4 wq[3][2];
#pragma unroll
        for (int k = 0; k < 3; ++k)
#pragma unroll
            for (int bj = 0; bj < 2; ++bj) wq[k][bj] = *(const f32x4*)(fw + k * DFF2 + bj * DFF + chb);
        {
            LAS float* RS = X + 2048;
            const int lane_e = fq * 16 + fr;
            if (lane_e < 32) { const int rr = (wr * 4 + wc) * 32 + lane_e; const float* sp = ssq + (size_t)(u.pm * BM + rr) * 4;
                const f32x4 a0 = *(const f32x4*)sp, a1 = *(const f32x4*)(sp + (size_t)T * 4), a2 = *(const f32x4*)(sp + (size_t)T * 8), a3 = *(const f32x4*)(sp + (size_t)T * 12);
                const float sq = ((a0.x + a0.y) + (a0.z + a0.w)) + ((a1.x + a1.y) + (a1.z + a1.w)) + ((a2.x + a2.y) + (a2.z + a2.w)) + ((a3.x + a3.y) + (a3.z + a3.w));
                RS[rr] = __builtin_amdgcn_rsqf(sq * (1.0f / DM) + EPS); }
            asm volatile("s_waitcnt lgkmcnt(0)" ::: "memory"); __builtin_amdgcn_s_barrier(); asm volatile("" ::: "memory");
#pragma unroll
            for (int ai = 0; ai < 2; ++ai)
#pragma unroll
                for (int m = 0; m < 4; ++m) { const float rs = RS[ai * HALF + wr * 64 + m * 16 + fr];
#pragma unroll
                    for (int bj = 0; bj < 2; ++bj)
#pragma unroll
                        for (int n = 0; n < 2; ++n) acc[ai][bj][m][n] = acc[ai][bj][m][n] * rs; }
        }
        if (fr >= 14) {
#pragma unroll
            for (int ai = 0; ai < 2; ++ai) { LAS float* p = X + ((((ai * 2 + wr) * 4 + wc) * 2 + (fr - 14)) * 4 + fq) * 16;
#pragma unroll
                for (int bj = 0; bj < 2; ++bj)
#pragma unroll
                    for (int n = 0; n < 2; ++n) *(LAS f32x4*)(p + bj * 8 + n * 4) = acc[ai][bj][3][n]; }
            if (wr == 1) { float* q = PRE + ((size_t)u.pm * 4 + 2 + (fr - 14)) * DFF2 + chb;
#pragma unroll
                for (int bj = 0; bj < 2; ++bj)
#pragma unroll
                    for (int n = 0; n < 2; ++n) *(f32x4*)(q + bj * DFF + 4 * n) = acc[1][bj][3][n]; }
        }
        if (wr == 0 && fr < 2) { float* q = PRE + ((size_t)u.pm * 4 + fr) * DFF2 + chb;
#pragma unroll
            for (int bj = 0; bj < 2; ++bj)
#pragma unroll
                for (int n = 0; n < 2; ++n) *(f32x4*)(q + bj * DFF + 4 * n) = acc[0][bj][0][n]; }
        asm volatile("s_waitcnt lgkmcnt(0)" ::: "memory"); __builtin_amdgcn_s_barrier(); asm volatile("" ::: "memory");
#pragma unroll
        for (int n = 0; n < 2; ++n) {
            f32x4 w[3][2];
#pragma unroll
            for (int k = 0; k < 3; ++k)
#pragma unroll
                for (int bj = 0; bj < 2; ++bj) w[k][bj] = (n == 0) ? wq[k][bj] : *(const f32x4*)(fw + k * DFF2 + bj * DFF + chb + 4);
#pragma unroll
            for (int ai = 0; ai < 2; ++ai)
#pragma unroll
                for (int m = 0; m < 4; ++m) {
                    f32x4 t1[2], t2[2];
                    if (m > 0) {
#pragma unroll
                        for (int bj = 0; bj < 2; ++bj)
#pragma unroll
                            for (int e = 0; e < 4; ++e) { const float pv = acc[ai][bj][m - 1][n][e]; t1[bj][e] = DPPF(pv, 0x10F); t2[bj][e] = DPPF(pv, 0x10E); }
                    } else {
                        const bool has_pred = (wr == 1) || (ai == 1);
                        const int pai = (wr == 1) ? ai : 0, pwr = (wr == 1) ? 0 : 1;
                        const LAS float* p14 = X + ((((pai * 2 + pwr) * 4 + wc) * 2 + 0) * 4 + fq) * 16; const LAS float* p15 = p14 + 64;
#pragma unroll
                        for (int bj = 0; bj < 2; ++bj) { const f32x4 r14 = *(const LAS f32x4*)(p14 + bj * 8 + n * 4), r15 = *(const LAS f32x4*)(p15 + bj * 8 + n * 4);
#pragma unroll
                            for (int e = 0; e < 4; ++e) { t1[bj][e] = (has_pred && fr == 0) ? r15[e] : 0.f; t2[bj][e] = has_pred ? (fr == 0 ? r14[e] : (fr == 1 ? r15[e] : 0.f)) : 0.f; } }
                    }
                    float h[2][4];
#pragma unroll
                    for (int bj = 0; bj < 2; ++bj)
#pragma unroll
                        for (int e = 0; e < 4; ++e) { const float cur = acc[ai][bj][m][n][e];
                            const float p1 = DPPF(cur, 0x111) + t1[bj][e], p2 = DPPF(cur, 0x112) + t2[bj][e];
                            h[bj][e] = w[0][bj][e] * p2 + w[1][bj][e] * p1 + w[2][bj][e] * cur; }
                    float r4[4];
#pragma unroll
                    for (int c = 0; c < 4; ++c) r4[c] = siluf_(h[0][c]) * h[1][c];
                    const bool skip = (ai == 0) && (m == 0) && (wr == 0) && (fr < 2);
                    if (!skip) { u32x2 o; o.x = cvt_pk_bf16(r4[0], r4[1]); o.y = cvt_pk_bf16(r4[2], r4[3]);
                        *(u32x2*)(ACT + (size_t)(u.pm * BM + ai * HALF + wr * 64 + m * 16 + fr) * DFF + chb + 4 * n) = o; }
                }
            asm volatile("" ::: "memory");
        }
    }
};

struct EpiResid {
    static constexpr bool PERM = false;
    const float* basef; const bf16_t* baseb; float* out; int ldc; bf16_t* hb; float* ssq;
    __device__ __forceinline__ bool keep(const Unit&) const { return false; }
    __device__ __forceinline__ void operator()(f32x4 (&acc)[2][2][4][2], const Unit& u, int wr, int wc, int fr, int fq) const {
        const int col0 = u.pn * BM + wc * 32 + 4 * fq;
#pragma unroll
        for (int ai = 0; ai < 2; ++ai) {
            u32x2 bb[4][2][2];
            if (!basef) {
#pragma unroll
                for (int m = 0; m < 4; ++m) { const size_t off = (size_t)(u.pm * BM + ai * HALF + wr * 64 + m * 16 + fr) * ldc + col0;
#pragma unroll
                    for (int bj = 0; bj < 2; ++bj)
#pragma unroll
                        for (int n = 0; n < 2; ++n) bb[m][bj][n] = *(const u32x2*)(baseb + off + bj * HALF + n * 16); }
            }
#pragma unroll
            for (int m = 0; m < 4; ++m) { const size_t row = (size_t)(u.pm * BM + ai * HALF + wr * 64 + m * 16 + fr); const size_t off = row * ldc + col0; float sq = 0.f;
#pragma unroll
                for (int bj = 0; bj < 2; ++bj)
#pragma unroll
                    for (int n = 0; n < 2; ++n) { f32x4 bs;
                        if (basef) bs = *(const f32x4*)(basef + off + bj * HALF + n * 16);
                        else { const u32x2 b2 = bb[m][bj][n]; bs = (f32x4){bflo(b2.x), bfhi(b2.x), bflo(b2.y), bfhi(b2.y)}; }
                        const f32x4 v = bs + acc[ai][bj][m][n];
                        if (out) *(f32x4*)(out + off + bj * HALF + n * 16) = v;
                        if (hb) { sq += (v.x * v.x + v.y * v.y) + (v.z * v.z + v.w * v.w); *(u32x2*)(hb + off + bj * HALF + n * 16) = (u32x2){cvt_pk_bf16(v.x, v.y), cvt_pk_bf16(v.z, v.w)}; } }
                if (hb) { sq += __shfl_xor(sq, 16); sq += __shfl_xor(sq, 32); if (fq == 0) ssq[((size_t)u.pn * T + row) * 4 + wc] = sq; } }
            asm volatile("" ::: "memory");
        }
    }
};

template <class Epi, class Sched, int NSEG, int KK, int LDA, int LDB>
__device__ __forceinline__ void gemm_phase(LAS unsigned char* lds, const Gemm g, const Sched& S, const Epi& E) {
    const int tid = fresh_tid(), wid = __builtin_amdgcn_readfirstlane(tid >> 6), lane = tid & 63, wr = wid >> 2, wc = wid & 3, fr = lane & 15, fq = lane >> 4;
    constexpr int nt = KK / BK;
    unsigned voffA[2], voffB[2];
#pragma unroll
    for (int i = 0; i < 2; ++i) { int R, C; stage_rc(tid * 16 + i * 8192, R, C); const int Rb = Epi::PERM ? ((R & ~31) + perm32(R & 31)) : R;
        voffA[i] = (unsigned)(R * LDA + C) * 2u; voffB[i] = (unsigned)(Rb * LDB + C) * 2u; }
    constexpr size_t kstep = (size_t)(BK * 2);
    constexpr size_t hstepA = (size_t)HALF * LDA * 2, hstepB = (size_t)HALF * LDB * 2;
    constexpr size_t tstepA = 2 * hstepA, tstepB = 2 * hstepB;
    const unsigned ldsw = (unsigned)wid * 1024u;
    const int aoff = lds_byte(wr * 64 + fr, fq * 8), boff = lds_byte(wc * 32 + fr, fq * 8);
#define PG8_SA(b, h) (((b) * 2 + (h)) * HTB)
#define PG8_SB(b, h) ((4 + (b) * 2 + (h)) * HTB)
#define PG8_STAGE(bufoff, gbase, voff) do { _Pragma("unroll") for (int _i = 0; _i < 2; ++_i) \
        __builtin_amdgcn_global_load_lds((const unsigned*)((const char*)(gbase) + (voff)[_i]), (LAS unsigned*)(lds + (bufoff) + ldsw + _i * 8192), 16, 0, 0); } while (0)
#define PG8_LDA(dst, b, h) do { _Pragma("unroll") for (int m = 0; m < 4; ++m) _Pragma("unroll") for (int k = 0; k < 2; ++k) dst[m][k] = *(const LAS bf16x8*)(lds + PG8_SA(b, h) + aoff + m * 2048 + k * 1024); } while (0)
#define PG8_LDB(dst, b, h) do { _Pragma("unroll") for (int n = 0; n < 2; ++n) _Pragma("unroll") for (int k = 0; k < 2; ++k) dst[n][k] = *(const LAS bf16x8*)(lds + PG8_SB(b, h) + boff + n * 2048 + k * 1024); } while (0)
#define PG8_MMA(ai, bj, At, Bt) do { __builtin_amdgcn_s_setprio(1); _Pragma("unroll") for (int m = 0; m < 4; ++m) _Pragma("unroll") for (int n = 0; n < 2; ++n) _Pragma("unroll") for (int k = 0; k < 2; ++k) \
        acc[ai][bj][m][n] = __builtin_amdgcn_mfma_f32_16x16x32_bf16(Bt[n][k], At[m][k], acc[ai][bj][m][n], 0, 0, 0); __builtin_amdgcn_s_setprio(0); } while (0)
#define PG8_WAIT_V(n) asm volatile("s_waitcnt vmcnt(" #n ")" ::: "memory")
#define PG8_WAIT_L(n) asm volatile("s_waitcnt lgkmcnt(" #n ")" ::: "memory")
#define PG8_BAR __builtin_amdgcn_s_barrier()
#define PG8_SCHED __builtin_amdgcn_sched_barrier(0)
#define PG8_APTR(u) ((const char*)((NSEG == 1 || (u).seg == 0) ? g.A0 : (u).seg == 1 ? g.A1 : g.A2) + (size_t)(u).pm * tstepA)
#define PG8_BPTR(u) ((const char*)((NSEG == 1 || (u).seg == 0) ? g.B0 : (u).seg == 1 ? g.B1 : g.B2) + (size_t)(u).pn * tstepB)
    Unit cur, nxt; int ui = 0;
    if (!S.next(0, cur)) return;
    f32x4 acc[2][2][4][2];
#pragma unroll
    for (int a = 0; a < 2; ++a)
#pragma unroll
        for (int b = 0; b < 2; ++b)
#pragma unroll
            for (int m = 0; m < 4; ++m)
#pragma unroll
                for (int n = 0; n < 2; ++n) acc[a][b][m][n] = (f32x4){0.f, 0.f, 0.f, 0.f};
    bf16x8 At[4][2], B0[2][2], B1[2][2];
    const char* cA = PG8_APTR(cur); const char* cB = PG8_BPTR(cur);
    PG8_STAGE(PG8_SB(0, 0), cB, voffB); PG8_STAGE(PG8_SB(0, 1), cB + hstepB, voffB); PG8_STAGE(PG8_SA(0, 0), cA, voffA); PG8_STAGE(PG8_SA(0, 1), cA + hstepA, voffA);
    if (wr == 1) PG8_BAR;
    PG8_WAIT_V(2); PG8_BAR;
    PG8_STAGE(PG8_SB(1, 0), cB + kstep, voffB); PG8_STAGE(PG8_SA(1, 0), cA + kstep, voffA); PG8_STAGE(PG8_SB(1, 1), cB + hstepB + kstep, voffB);
    PG8_WAIT_V(6); PG8_BAR;
    for (;;) {
        const bool has_next = S.next(ui + 1, nxt);
        const char* nA = has_next ? PG8_APTR(nxt) : cA; const char* nB = has_next ? PG8_BPTR(nxt) : cB;
        for (int t = 0; t < nt; t += 2) {
            const bool last = (t == nt - 2);
            const char* a1 = cA + (size_t)(t + 1) * kstep;
            const char* a2 = last ? nA : cA + (size_t)(t + 2) * kstep; const char* b2 = last ? nB : cB + (size_t)(t + 2) * kstep;
            const char* a3 = a2 + kstep; const char* b3 = b2 + kstep;
            PG8_LDB(B0, 0, 0); PG8_LDB(B1, 0, 1); PG8_SCHED; PG8_LDA(At, 0, 0); PG8_STAGE(PG8_SA(1, 1), a1 + hstepA, voffA);
            PG8_WAIT_V(8); PG8_WAIT_L(0); PG8_BAR; PG8_MMA(0, 0, At, B0); PG8_MMA(0, 1, At, B1); PG8_BAR; PG8_SCHED;
            PG8_LDA(At, 0, 1); PG8_STAGE(PG8_SB(0, 0), b2, voffB); PG8_STAGE(PG8_SB(0, 1), b2 + hstepB, voffB); PG8_STAGE(PG8_SA(0, 0), a2, voffA);
            PG8_WAIT_V(8); PG8_WAIT_L(0); PG8_BAR; PG8_MMA(1, 0, At, B0); PG8_MMA(1, 1, At, B1); PG8_BAR; PG8_SCHED;
            PG8_LDB(B0, 1, 0); PG8_LDB(B1, 1, 1); PG8_SCHED; PG8_LDA(At, 1, 0); PG8_STAGE(PG8_SA(0, 1), a2 + hstepA, voffA);
            PG8_WAIT_V(8); PG8_WAIT_L(0); PG8_BAR; PG8_MMA(0, 0, At, B0); PG8_MMA(0, 1, At, B1); PG8_BAR; PG8_SCHED;
            PG8_LDA(At, 1, 1); PG8_STAGE(PG8_SB(1, 0), b3, voffB); PG8_STAGE(PG8_SB(1, 1), b3 + hstepB, voffB); PG8_STAGE(PG8_SA(1, 0), a3, voffA);
            PG8_WAIT_V(8); PG8_WAIT_L(0); PG8_BAR; PG8_MMA(1, 0, At, B0); PG8_MMA(1, 1, At, B1); PG8_BAR; PG8_SCHED;
        }
        if (wr == 0) PG8_BAR;
        { const int t_e = fresh_tid(); int fr_e = t_e & 15, fq_e = (t_e >> 4) & 3; int wr_e = wr, wc_e = wc; asm volatile("" : "+s"(wr_e), "+s"(wc_e));
          E(acc, cur, wr_e, wc_e, fr_e, fq_e); }
        if (!has_next) break;
        if (!E.keep(cur)) {
#pragma unroll
            for (int a = 0; a < 2; ++a)
#pragma unroll
                for (int b = 0; b < 2; ++b)
#pragma unroll
                    for (int m = 0; m < 4; ++m)
#pragma unroll
                        for (int n = 0; n < 2; ++n) acc[a][b][m][n] = (f32x4){0.f, 0.f, 0.f, 0.f};
        }
        cur = nxt; cA = nA; cB = nB; ++ui;
        if (wr == 1) PG8_BAR;
    }
    PG8_WAIT_V(0);
    PG8_BAR;
#undef PG8_SA
#undef PG8_SB
#undef PG8_STAGE
#undef PG8_LDA
#undef PG8_LDB
#undef PG8_MMA
#undef PG8_WAIT_V
#undef PG8_WAIT_L
#undef PG8_BAR
#undef PG8_SCHED
#undef PG8_APTR
#undef PG8_BPTR
}
}

template <bool UPMAP = false>
__device__ __forceinline__ void transpose_item(const float* W, int ldw, int ncols, bf16_t* WT, int K, int row_off, LAS float* scr, int item, int lane, const float* gk = nullptr) {
    const int nblk = ncols / 32, kb = item / nblk, nb = item % nblk, k0 = 64 * kb, n0 = 32 * nb;
    if (UPMAP) { const int c2 = n0 < DFF ? n0 : n0 - DFF; row_off = 256 * (c2 >> 7) + (n0 < DFF ? 0 : 128) + (c2 & 127) - n0; }
#pragma unroll
    for (int i = 0; i < 32; ++i) { const int kk = 2 * i + (lane >> 5); float wv = W[(size_t)(k0 + kk) * ldw + n0 + (lane & 31)]; if (gk) wv *= gk[k0 + kk]; scr[kk * 33 + (lane & 31)] = wv; }
    LDS_WAIT(); asm volatile("" ::: "memory");
    const int c = lane & 7;
#pragma unroll
    for (int j = 0; j < 4; ++j) { const int n = (lane >> 3) + 8 * j; const LAS float* s = scr + (8 * c) * 33 + n;
        u32x4 o; o.x = pk2(s[0 * 33], s[1 * 33]); o.y = pk2(s[2 * 33], s[3 * 33]); o.z = pk2(s[4 * 33], s[5 * 33]); o.w = pk2(s[6 * 33], s[7 * 33]);
        *(u32x4*)(WT + (size_t)(row_off + n0 + n) * K + k0 + 8 * c) = o; }
    LDS_WAIT(); asm volatile("" ::: "memory");
}
__device__ __forceinline__ void rms_row_to_bf16(const float* xrow, const float* g, bf16_t* orow, int lane) {
    const f32x4* xr = (const f32x4*)xrow + lane; const f32x4* gr = (const f32x4*)g + lane;
    f32x4 v[4]; float s = 0.f;
#pragma unroll
    for (int j = 0; j < 4; ++j) { v[j] = xr[64 * j]; s += (v[j].x * v[j].x + v[j].y * v[j].y) + (v[j].z * v[j].z + v[j].w * v[j].w); }
    const float rstd = 1.0f / sqrtf(wave_sum(s) * (1.f / DM) + EPS);
    unsigned long long* o8 = (unsigned long long*)orow + lane;
#pragma unroll
    for (int j = 0; j < 4; ++j) { const f32x4 gg = gr[64 * j];
        o8[64 * j] = (unsigned long long)pk2(v[j].x * rstd * gg.x, v[j].y * rstd * gg.y) | ((unsigned long long)pk2(v[j].z * rstd * gg.z, v[j].w * rstd * gg.w) << 32); }
}
__device__ __forceinline__ void rms_2rows_to_bf16(const float* x0, const float* x1, const float* g, bf16_t* o0, bf16_t* o1, int lane) {
    const f32x4* xa = (const f32x4*)x0 + lane; const f32x4* xb = (const f32x4*)x1 + lane; const f32x4* gr = (const f32x4*)g + lane;
    f32x4 va[4], vb[4]; float sa = 0.f, sb = 0.f;
#pragma unroll
    for (int j = 0; j < 4; ++j) { va[j] = xa[64 * j]; vb[j] = xb[64 * j]; }
#pragma unroll
    for (int j = 0; j < 4; ++j) { sa += (va[j].x * va[j].x + va[j].y * va[j].y) + (va[j].z * va[j].z + va[j].w * va[j].w); sb += (vb[j].x * vb[j].x + vb[j].y * vb[j].y) + (vb[j].z * vb[j].z + vb[j].w * vb[j].w); }
    const float ra = 1.0f / sqrtf(wave_sum(sa) * (1.f / DM) + EPS), rb = 1.0f / sqrtf(wave_sum(sb) * (1.f / DM) + EPS);
    unsigned long long* pa = (unsigned long long*)o0 + lane; unsigned long long* pb = (unsigned long long*)o1 + lane;
#pragma unroll
    for (int j = 0; j < 4; ++j) { const f32x4 gg = gr[64 * j];
        pa[64 * j] = (unsigned long long)pk2(va[j].x * ra * gg.x, va[j].y * ra * gg.y) | ((unsigned long long)pk2(va[j].z * ra * gg.z, va[j].w * ra * gg.w) << 32);
        pb[64 * j] = (unsigned long long)pk2(vb[j].x * rb * gg.x, vb[j].y * rb * gg.y) | ((unsigned long long)pk2(vb[j].z * rb * gg.z, vb[j].w * rb * gg.w) << 32); }
}
__device__ __forceinline__ void rms_row_f32_inplace(float* xrow, const float* g, int lane) {
    f32x4* xr = (f32x4*)xrow + lane; const f32x4* gr = (const f32x4*)g + lane;
    f32x4 v[4]; float s = 0.f;
#pragma unroll
    for (int j = 0; j < 4; ++j) { v[j] = xr[64 * j]; s += (v[j].x * v[j].x + v[j].y * v[j].y) + (v[j].z * v[j].z + v[j].w * v[j].w); }
    const float rstd = 1.0f / sqrtf(wave_sum(s) * (1.f / DM) + EPS);
#pragma unroll
    for (int j = 0; j < 4; ++j) { const f32x4 gg = gr[64 * j]; xr[64 * j] = v[j] * rstd * gg; }
}

__device__ __forceinline__ f32x4 mfma16(bf16x8 a, bf16x8 b, f32x4 c) { return __builtin_amdgcn_mfma_f32_16x16x32_bf16(a, b, c, 0, 0, 0); }

template <bool FULL>
__device__ __forceinline__ void gla_segment(LAS unsigned char* L, bf16_t* Z, const float* w_alpha, const float* b_alpha, const float* norm_g, int unit, float* Sbuf, float* Btot) {
    const int tid = fresh_tid(), lane = tid & 63, w = tid >> 6, quad = lane >> 4, l15 = lane & 15;
    const int kcol = tid & 127, qtr = tid >> 7;
    const int b = unit >> 5, h = (unit >> 3) & 3, seg = unit & 7;
    LAS bf16_t* QI = (LAS bf16_t*)(L + 0);
    LAS bf16_t* KI = (LAS bf16_t*)(L + 17408);
    LAS float*  OL = (LAS float*)(L + 0);
    LAS bf16_t* QT = (LAS bf16_t*)(L + 34816);
    LAS bf16_t* KTt = (LAS bf16_t*)(L + 52224);
    LAS bf16_t* Vt = (LAS bf16_t*)(L + 70656);
    LAS bf16_t* Pm = (LAS bf16_t*)(L + 89088);
    LAS bf16_t* St = (LAS bf16_t*)(L + 98304);
    LAS float*  GAs = (LAS float*)(L + 133120);
    LAS float*  PART = (LAS float*)(L + 137216);
    LAS float*  Dd = (LAS float*)(L + 139264);

    float wa[16];
#pragma unroll
    for (int r = 0; r < 16; ++r) wa[r] = w_alpha[r * 512 + h * 128 + kcol] * 1.4426950408889634f;
    const float ba = b_alpha[h * 128 + kcol] * 1.4426950408889634f;
    f32x4 S[8];
#pragma unroll
    for (int t = 0; t < 8; ++t) S[t] = (f32x4){0.f, 0.f, 0.f, 0.f};
    float btot = 0.f;
    if (FULL) {
        if (seg > 0) {
            float cv[32], cb4[4], nv[32], nb4[4];
            { const int up = unit - seg; const float* sb = Sbuf + (size_t)up * 16384 + tid;
#pragma unroll
              for (int j = 0; j < 4; ++j) cb4[j] = Btot[up * 128 + w * 16 + quad * 4 + j];
#pragma unroll
              for (int q = 0; q < 32; ++q) cv[q] = sb[q * 512]; }
            for (int sp = 0; sp < seg; ++sp) {
                const bool hn = sp + 1 < seg; const int upn = unit - seg + (hn ? sp + 1 : sp); const float* sbn = Sbuf + (size_t)upn * 16384 + tid;
#pragma unroll
                for (int j = 0; j < 4; ++j) nb4[j] = Btot[upn * 128 + w * 16 + quad * 4 + j];
#pragma unroll
                for (int q = 0; q < 32; ++q) nv[q] = sbn[q * 512];
                float d[4];
#pragma unroll
                for (int j = 0; j < 4; ++j) d[j] = __builtin_amdgcn_exp2f(cb4[j]);
#pragma unroll
                for (int t = 0; t < 8; ++t)
#pragma unroll
                    for (int j = 0; j < 4; ++j) S[t][j] = S[t][j] * d[j] + cv[t * 4 + j];
#pragma unroll
                for (int j = 0; j < 4; ++j) cb4[j] = nb4[j];
#pragma unroll
                for (int q = 0; q < 32; ++q) cv[q] = nv[q];
            }
        }
#pragma unroll
        for (int t = 0; t < 8; ++t) *(LAS u32x2*)(St + (t * 16 + l15) * 136 + w * 16 + quad * 4) = (u32x2){pk2(S[t][0], S[t][1]), pk2(S[t][2], S[t][3])}    ;
    }
    __syncthreads();

    unsigned short qraw[16], kraw[16], vraw[16], garaw[2], knx[16], vnx[16], ganx[2];
#define GLA_ISSUE(nn) do { const size_t tb_ = (size_t)b * SEQ + (size_t)(seg * 8 + (nn)) * 64; const bf16_t* zq_ = Z + (tb_ + qtr * 16) * ZLD + h * 128 + kcol; \
        _Pragma("unroll") for (int r = 0; r < 16; ++r) { asm volatile("" : "+v"(zq_)); if (FULL) { qraw[r] = zq_[ZQ]; kraw[r] = zq_[ZK]; vraw[r] = zq_[ZV]; } else { knx[r] = zq_[ZK]; vnx[r] = zq_[ZV]; } zq_ += ZLD; } \
        const unsigned short g0_ = Z[(tb_ + (tid >> 4)) * ZLD + ZGA + (tid & 15)], g1_ = Z[(tb_ + 32 + (tid >> 4)) * ZLD + ZGA + (tid & 15)]; \
        if (FULL) { garaw[0] = g0_; garaw[1] = g1_; } else { ganx[0] = g0_; ganx[1] = g1_; } } while (0)
#define GLA_ROTATE() do { if (!FULL) { _Pragma("unroll") for (int r = 0; r < 16; ++r) { kraw[r] = knx[r]; vraw[r] = vnx[r]; } garaw[0] = ganx[0]; garaw[1] = ganx[1]; } } while (0)
    GLA_ISSUE(0); GLA_ROTATE();
    for (int n = 0; n < 8; ++n) {
        const size_t tb = (size_t)b * SEQ + (size_t)(seg * 8 + n) * 64;
        if (!FULL && n + 1 < 8) GLA_ISSUE(n + 1);
        GAs[tid] = bf2f(garaw[0]); GAs[tid + 512] = bf2f(garaw[1]);
        __syncthreads();
        float c[16]; float run = 0.f;
#pragma unroll
        for (int r = 0; r < 16; ++r) { const int i = qtr * 16 + r;
            const LAS f32x4* gp = (const LAS f32x4*)(GAs + i * 16);
            f32x2 a2 = (f32x2){ba, 0.f};
#pragma unroll
            for (int q4 = 0; q4 < 4; ++q4) { const f32x4 g4 = gp[q4];
                a2 = a2 + (f32x2){g4.x, g4.y} * (f32x2){wa[4 * q4], wa[4 * q4 + 1]}; a2 = a2 + (f32x2){g4.z, g4.w} * (f32x2){wa[4 * q4 + 2], wa[4 * q4 + 3]}; }
            const float x = a2.x + a2.y;
            const float ls = fminf(x, 0.f) - __builtin_amdgcn_logf(1.0f + __builtin_amdgcn_exp2f(-fabsf(x)));
            run += ls * (1.0f / 16.0f); c[r] = run; }
        PART[qtr * 128 + kcol] = run;
        __syncthreads();
        const float p0 = PART[kcol], p1 = PART[128 + kcol], p2 = PART[256 + kcol], p3 = PART[384 + kcol];
        const float off = (qtr > 0 ? p0 : 0.f) + (qtr > 1 ? p1 : 0.f) + (qtr > 2 ? p2 : 0.f);
        const float bref = p0 + p1, blast = (p0 + p1) + (p2 + p3);
        btot += blast;
        {
            const float ebr = __builtin_amdgcn_exp2f(bref), elb = __builtin_amdgcn_exp2f(blast - bref);
            unsigned ktp[8], vp[8];
#pragma unroll
            for (int r = 0; r < 16; ++r) { const int i = qtr * 16 + r; const float bi = off + c[r];
                const float e1 = __builtin_amdgcn_exp2f(bi - bref), e1r = __builtin_amdgcn_exp2f(bref - bi);
                const float k = bf2f(kraw[r]); const unsigned vb = vraw[r];
                if (FULL) { const float q = bf2f(qraw[r]) * 0.08838834764831845f;
                    QI[i * 136 + kcol] = (bf16_t)hwbf(q * e1); KI[i * 136 + kcol] = (bf16_t)hwbf(k * e1r); QT[i * 136 + kcol] = (bf16_t)hwbf(q * e1 * ebr); }
                const unsigned kt = hwbf(k * e1r * elb);
                if (r & 1) { ktp[r >> 1] |= kt << 16; vp[r >> 1] |= vb << 16; } else { ktp[r >> 1] = kt; vp[r >> 1] = vb; } }
            *(LAS u32x4*)(KTt + kcol * 72 + qtr * 16) = (u32x4){ktp[0], ktp[1], ktp[2], ktp[3]}; *(LAS u32x4*)(KTt + kcol * 72 + qtr * 16 + 8) = (u32x4){ktp[4], ktp[5], ktp[6], ktp[7]};
            *(LAS u32x4*)(Vt + kcol * 72 + qtr * 16) = (u32x4){vp[0], vp[1], vp[2], vp[3]}; *(LAS u32x4*)(Vt + kcol * 72 + qtr * 16 + 8) = (u32x4){vp[4], vp[5], vp[6], vp[7]};
            if (qtr == 0) Dd[kcol] = __builtin_amdgcn_exp2f(blast);
        }
        __syncthreads();
        if (FULL && n + 1 < 8) GLA_ISSUE(n + 1);
        const int oi = tid >> 3, vs = (tid & 7) * 16;
        bf16_t* zr = Z + (tb + oi) * ZLD + ZR + h * 128 + vs;
        u32x4 g8[2];
        if (FULL) { g8[0] = *(const u32x4*)zr; g8[1] = *(const u32x4*)(zr + 8); }
        if (FULL) {
            {
                const int mi = w >> 1;
#pragma unroll
                for (int nn = 0; nn < 2; ++nn) { const int nj = (w & 1) * 2 + nn; f32x4 a4 = (f32x4){0.f, 0.f, 0.f, 0.f};
#pragma unroll
                    for (int ks = 0; ks < 4; ++ks) a4 = mfma16(*(const LAS bf16x8*)(QI + (mi * 16 + l15) * 136 + ks * 32 + quad * 8), *(const LAS bf16x8*)(KI + (nj * 16 + l15) * 136 + ks * 32 + quad * 8), a4);
#pragma unroll
                    for (int j = 0; j < 4; ++j) { const int i = mi * 16 + quad * 4 + j, jj = nj * 16 + l15; Pm[i * 72 + jj] = (bf16_t)hwbf(jj <= i ? a4[j] : 0.f); } }
            }
            __syncthreads();
            {
                const int mi = w >> 1; f32x4 o4[4];
#pragma unroll
                for (int t = 0; t < 4; ++t) o4[t] = (f32x4){0.f, 0.f, 0.f, 0.f};
#pragma unroll
                for (int ks = 0; ks < 2; ++ks) { const bf16x8 a = *(const LAS bf16x8*)(Pm + (mi * 16 + l15) * 72 + ks * 32 + quad * 8);
#pragma unroll
                    for (int t = 0; t < 4; ++t) { const int nv = (w & 1) * 4 + t; o4[t] = mfma16(a, *(const LAS bf16x8*)(Vt + (nv * 16 + l15) * 72 + ks * 32 + quad * 8), o4[t]); } }
#pragma unroll
                for (int ks = 0; ks < 4; ++ks) { const bf16x8 a = *(const LAS bf16x8*)(QT + (mi * 16 + l15) * 136 + ks * 32 + quad * 8);
#pragma unroll
                    for (int t = 0; t < 4; ++t) { const int nv = (w & 1) * 4 + t; o4[t] = mfma16(a, *(const LAS bf16x8*)(St + (nv * 16 + l15) * 136 + ks * 32 + quad * 8), o4[t]); } }
#pragma unroll
                for (int t = 0; t < 4; ++t) { const int nv = (w & 1) * 4 + t;
#pragma unroll
                    for (int j = 0; j < 4; ++j) OL[(mi * 16 + quad * 4 + j) * 132 + nv * 16 + l15] = o4[t][j]; }
            }
            __syncthreads();
        }
        {
            float dk[4];
#pragma unroll
            for (int j = 0; j < 4; ++j) dk[j] = Dd[w * 16 + quad * 4 + j];
            bf16x8 ka[2];
#pragma unroll
            for (int ks = 0; ks < 2; ++ks) ka[ks] = *(const LAS bf16x8*)(KTt + (w * 16 + l15) * 72 + ks * 32 + quad * 8);
#pragma unroll
            for (int t = 0; t < 8; ++t) {
#pragma unroll
                for (int j = 0; j < 4; ++j) S[t][j] *= dk[j];
#pragma unroll
                for (int ks = 0; ks < 2; ++ks) S[t] = mfma16(ka[ks], *(const LAS bf16x8*)(Vt + (t * 16 + l15) * 72 + ks * 32 + quad * 8), S[t]);
                if (FULL) *(LAS u32x2*)(St + (t * 16 + l15) * 136 + w * 16 + quad * 4) = (u32x2){pk2(S[t][0], S[t][1]), pk2(S[t][2], S[t][3])}    ;
            }
        }
        if (FULL) {
            f32x4 ov[4]; float ss = 0.f;
#pragma unroll
            for (int e = 0; e < 4; ++e) { ov[e] = *(const LAS f32x4*)(OL + oi * 132 + vs + 4 * e); ss += (ov[e].x * ov[e].x + ov[e].y * ov[e].y) + (ov[e].z * ov[e].z + ov[e].w * ov[e].w); }
            ss += __shfl_xor(ss, 1); ss += __shfl_xor(ss, 2); ss += __shfl_xor(ss, 4);
            const float rstd = __builtin_amdgcn_rsqf(ss * (1.0f / 128.0f) + EPS);
            const float* ng = norm_g + h * 128 + vs;
#pragma unroll
            for (int hh = 0; hh < 2; ++hh) {
                const float gr[8] = {bflo(g8[hh].x), bfhi(g8[hh].x), bflo(g8[hh].y), bfhi(g8[hh].y), bflo(g8[hh].z), bfhi(g8[hh].z), bflo(g8[hh].w), bfhi(g8[hh].w)};
                const f32x4 n0 = *(const f32x4*)(ng + 8 * hh), n1 = *(const f32x4*)(ng + 8 * hh + 4);
                const f32x4 a0 = ov[2 * hh], a1 = ov[2 * hh + 1];
                float r8[8];
#pragma unroll
                for (int e = 0; e < 4; ++e) { r8[e] = a0[e] * rstd * n0[e] * siluf_(gr[e]); r8[4 + e] = a1[e] * rstd * n1[e] * siluf_(gr[4 + e]); }
                *(u32x4*)(zr + 8 * hh) = (u32x4){cvt_pk_bf16(r8[0], r8[1]), cvt_pk_bf16(r8[2], r8[3]), cvt_pk_bf16(r8[4], r8[5]), cvt_pk_bf16(r8[6], r8[7])}; }
        }
        if (n + 1 < 8) GLA_ROTATE();
    }
    if (!FULL) {
        float* sb = Sbuf + (size_t)unit * 16384 + tid;
#pragma unroll
        for (int t = 0; t < 8; ++t)
#pragma unroll
            for (int j = 0; j < 4; ++j) sb[(t * 4 + j) * 512] = S[t][j];
        if (qtr == 0) Btot[unit * 128 + kcol] = btot;
    }
    __syncthreads();
}


__device__ __forceinline__ void swa_unit(LAS unsigned char* L, bf16_t* Z, const float* sinks, int b, int qb, int kvh) {
    const int tid = fresh_tid(), lane = tid & 63, w = tid >> 6, quad = lane >> 4, l15 = lane & 15;
    LAS bf16_t* Ks = (LAS bf16_t*)(L + 0);
    LAS bf16_t* Vt = (LAS bf16_t*)(L + 36864);
    LAS bf16_t* Pw = (LAS bf16_t*)(L + 72704 + w * 5376);
    const int t0 = qb * 128; const size_t rowbase = (size_t)b * SEQ;
    const int g = w >> 1, hq = kvh * 4 + g, half = w & 1;
    bf16x8 qf[4][2];
#pragma unroll
    for (int rt = 0; rt < 4; ++rt) { const bf16_t* qp = Z + (rowbase + t0 + 64 * half + 16 * rt + l15) * ZLD + ZSQ + hq * 64 + quad * 8; qf[rt][0] = *(const bf16x8*)qp; qf[rt][1] = *(const bf16x8*)(qp + 32); }
    for (int idx = tid; idx < 2048; idx += NTHREADS) { const int row = idx >> 3, c8 = idx & 7; const int tk = t0 - 128 + row;
        u32x4 v = (u32x4){0u, 0u, 0u, 0u}; if (tk >= 0) v = *(const u32x4*)(Z + (rowbase + tk) * ZLD + ZSK + kvh * 64 + c8 * 8);
        *(LAS u32x4*)(Ks + row * 72 + c8 * 8) = v; }
#pragma unroll
    for (int g = 0; g < 4; ++g) { const int kg = w * 4 + g; unsigned pk[4];
#pragma unroll
        for (int jj = 0; jj < 8; ++jj) { const int tk = t0 - 128 + kg * 8 + jj; unsigned vb = 0u; if (tk >= 0) vb = Z[(rowbase + tk) * ZLD + ZSV + kvh * 64 + lane];
            if (jj & 1) pk[jj >> 1] |= vb << 16; else pk[jj >> 1] = vb; }
        *(LAS u32x4*)(Vt + lane * 280 + kg * 8) = (u32x4){pk[0], pk[1], pk[2], pk[3]}; }
    { unsigned zr; asm volatile("v_mov_b32 %0, 0" : "=v"(zr)); const u32x4 zv = (u32x4){zr, zr, zr, zr};
      if (tid < 128) *(LAS u32x4*)(Vt + (tid >> 1) * 280 + 256 + (tid & 1) * 8) = zv;
      if (lane < 32) *(LAS u32x4*)(Pw + (lane >> 1) * 168 + 144 + (lane & 1) * 8) = zv; }
    __syncthreads();
    const float slope = exp2f(-(float)(hq + 1)); const float sink = sinks[hq];
#pragma unroll
    for (int rt = 0; rt < 4; ++rt) {
        const int kbase = 64 * half + 16 * rt;
        const bf16x8 qa0 = qf[rt][0], qa1 = qf[rt][1];
        f32x4 sc[9];
#pragma unroll
        for (int n = 0; n < 9; ++n) { const LAS bf16_t* kb = Ks + (kbase + 16 * n + l15) * 72 + quad * 8; f32x4 a4 = (f32x4){0.f, 0.f, 0.f, 0.f};
            a4 = mfma16(qa0, *(const LAS bf16x8*)kb, a4); a4 = mfma16(qa1, *(const LAS bf16x8*)(kb + 32), a4); sc[n] = a4; }
        float mx[4] = {sink, sink, sink, sink};
#pragma unroll
        for (int n = 0; n < 9; ++n)
#pragma unroll
            for (int j = 0; j < 4; ++j) { const int qi = kbase + quad * 4 + j, kk = kbase + 16 * n + l15; const int dist = qi + 128 - kk;
                const bool valid = (dist >= 0) && (dist < 128) && (t0 - 128 + kk >= 0);
                const float lg = valid ? sc[n][j] * 0.125f - slope * (float)dist : -INFINITY; sc[n][j] = lg; mx[j] = fmaxf(mx[j], lg); }
#pragma unroll
        for (int j = 0; j < 4; ++j) { mx[j] = fmaxf(mx[j], __shfl_xor(mx[j], 1)); mx[j] = fmaxf(mx[j], __shfl_xor(mx[j], 2)); mx[j] = fmaxf(mx[j], __shfl_xor(mx[j], 4)); mx[j] = fmaxf(mx[j], __shfl_xor(mx[j], 8)); }
        float sum[4] = {0.f, 0.f, 0.f, 0.f};
#pragma unroll
        for (int n = 0; n < 9; ++n)
#pragma unroll
            for (int j = 0; j < 4; ++j) { const float p = __expf(sc[n][j] - mx[j]); sum[j] += p; Pw[(quad * 4 + j) * 168 + 16 * n + l15] = (bf16_t)hwbf(p); }
        float rden[4];
#pragma unroll
        for (int j = 0; j < 4; ++j) { sum[j] += __shfl_xor(sum[j], 1); sum[j] += __shfl_xor(sum[j], 2); sum[j] += __shfl_xor(sum[j], 4); sum[j] += __shfl_xor(sum[j], 8);
            rden[j] = __builtin_amdgcn_rcpf(sum[j] + __expf(sink - mx[j])); }
        asm volatile("s_waitcnt lgkmcnt(0)" ::: "memory");
        f32x4 o4[4];
#pragma unroll
        for (int nd = 0; nd < 4; ++nd) o4[nd] = (f32x4){0.f, 0.f, 0.f, 0.f};
#pragma unroll
        for (int ks = 0; ks < 5; ++ks) { const bf16x8 a = *(const LAS bf16x8*)(Pw + l15 * 168 + ks * 32 + quad * 8);
#pragma unroll
            for (int nd = 0; nd < 4; ++nd) o4[nd] = mfma16(a, *(const LAS bf16x8*)(Vt + (nd * 16 + l15) * 280 + kbase + ks * 32 + quad * 8), o4[nd]); }
#pragma unroll
        for (int nd = 0; nd < 4; ++nd)
#pragma unroll
            for (int j = 0; j < 4; ++j) Z[(rowbase + t0 + kbase + quad * 4 + j) * ZLD + ZSQ + hq * 64 + nd * 16 + l15] = (bf16_t)hwbf(o4[nd][j] * rden[j]);
        asm volatile("s_waitcnt lgkmcnt(0)" ::: "memory");
    }
    __syncthreads();
}


#define XB_TMO      128
#define XB_XCNT(j)  (256  + 64 * (j))
#define XB_XSUB(j)  (1280 + 64 * (j))
#define XB_XGEN(j)  (2304 + 64 * (j))
#define XB_TOP      3328
#define XB_TOPGEN   3392
#define XCD_BAR_WORDS 3456
#define XB_SPIN_CAP (1u << 18)
__device__ __forceinline__ unsigned xb_ld(unsigned* p)              { return __hip_atomic_load(p, __ATOMIC_RELAXED, __HIP_MEMORY_SCOPE_AGENT); }
__device__ __forceinline__ unsigned xb_add(unsigned* p, unsigned v) { return __hip_atomic_fetch_add(p, v, __ATOMIC_RELAXED, __HIP_MEMORY_SCOPE_AGENT); }
__device__ __forceinline__ unsigned xb_xcc_id() { return (unsigned)__builtin_amdgcn_s_getreg((3 << 11) | 20) & 0xFu; }
#define XB_SPIN(cond, bar) do { unsigned _sp = 0; while (cond) { __builtin_amdgcn_s_sleep(1); \
    if ((++_sp & 255u) == 0u) { if (xb_ld(&(bar)[XB_TMO])) break; if (_sp > XB_SPIN_CAP) { atomicAdd(&(bar)[XB_TMO], 1u); break; } } } } while (0)
struct XcdBarrier { unsigned* bar; unsigned x; volatile LAS unsigned* st; };
__device__ __forceinline__ XcdBarrier xcd_barrier_post(unsigned* bar, volatile LAS unsigned* st) {
    XcdBarrier b; b.bar = bar; b.x = xb_xcc_id(); b.st = st;
    if (threadIdx.x == 0) (void)xb_add(&bar[XB_XCNT(b.x)], 1u);
    return b;
}
__device__ __forceinline__ void xcd_barrier_complete(unsigned* bar, unsigned x, unsigned& nloc, unsigned& nx) {
    const unsigned G = gridDim.x * gridDim.y * gridDim.z;
    unsigned sum, cnt, mine, sp = 0u;
    for (;;) {
        sum = 0u; cnt = 0u; mine = 0u;
#pragma unroll
        for (unsigned j = 0; j < 16; ++j) { const unsigned c = xb_ld(&bar[XB_XCNT(j)]); sum += c; cnt += (c > 0u) ? 1u : 0u; mine = (j == x) ? c : mine; }
        if (sum == G) break;
        __builtin_amdgcn_s_sleep(1);
        if ((++sp & 255u) == 0u) { if (xb_ld(&bar[XB_TMO])) break; if (sp > XB_SPIN_CAP) { atomicAdd(&bar[XB_TMO], 1u); break; } }
    }
    nloc = mine > 0u ? mine : 1u; nx = cnt > 0u ? cnt : 1u;
}
__device__ __forceinline__ void xcd_barrier(const XcdBarrier& b) {
    asm volatile("s_waitcnt vmcnt(0)" ::: "memory");
    __syncthreads();
    if (threadIdx.x == 0) {
        unsigned* bar = b.bar; asm volatile("" : "+s"(bar));
        __builtin_amdgcn_s_waitcnt(0);
        unsigned nloc = b.st[0], nx = b.st[1];
        if (nloc == 0u) { xcd_barrier_complete(bar, b.x, nloc, nx); b.st[0] = nloc; b.st[1] = nx; }
        const unsigned old = xb_add(&bar[XB_XSUB(b.x)], 1u);
        const unsigned gen = old / nloc;
        if (old + 1u == (gen + 1u) * nloc) {
            __builtin_amdgcn_fence(__ATOMIC_RELEASE, "agent");
            asm volatile("s_waitcnt vmcnt(0)" ::: "memory");
            const unsigned og = xb_add(&bar[XB_TOP], 1u);
            const unsigned tg = og / nx;
            if (og + 1u == (tg + 1u) * nx) xb_add(&bar[XB_TOPGEN], 1u);
            else XB_SPIN(xb_ld(&bar[XB_TOPGEN]) == tg, bar);
            __builtin_amdgcn_fence(__ATOMIC_ACQUIRE, "agent");
            xb_add(&bar[XB_XGEN(b.x)], 1u);
            asm volatile("s_waitcnt vmcnt(0)" ::: "memory");
        } else {
            XB_SPIN(xb_ld(&bar[XB_XGEN(b.x)]) == gen, bar);
            __builtin_amdgcn_fence(__ATOMIC_ACQUIRE, "agent");
            asm volatile("s_waitcnt vmcnt(0)" ::: "memory");
        }
    }
    __syncthreads();
}

struct Args { const float* in[17]; float* out; unsigned char* ws; };

__global__ void __launch_bounds__(NTHREADS, 2) mega_fwd(Args args) {
    extern __shared__ __attribute__((aligned(16))) unsigned char lds_raw[];
    LAS unsigned char* lds = (LAS unsigned char*)lds_raw;
    cg::grid_group grid = cg::this_grid();
    const int G = gridDim.x, blk = blockIdx.x, NGW = G * 8;
#define FRESH_IDS() const int tid = fresh_tid(), lane = tid & 63, wave = __builtin_amdgcn_readfirstlane(tid >> 6), gw = blk * 8 + wave; (void)lane; (void)gw
    const float* x = args.in[0]; float* out = args.out;
    bf16_t* Wb = (bf16_t*)(args.ws + WS_W);
    bf16_t* U = (bf16_t*)(args.ws + WS_U);
    bf16_t* Z = (bf16_t*)(args.ws + WS_BIG);
    bf16_t* MRG = (bf16_t*)(args.ws + WS_BIG + 288 * MiB);
    float* SSQ = (float*)(args.ws + WS_SSQ);
    bf16_t* ACT = (bf16_t*)(args.ws + WS_BIG);
    float* PRE = (float*)(args.ws + WS_BIG + 176 * MiB);

    volatile LAS unsigned* MISC = (volatile LAS unsigned*)(lds + LDS_BYTES - 64);
    unsigned* barw = (unsigned*)(args.ws + WS_BAR);
    { FRESH_IDS(); if (tid < 16) MISC[tid] = 0u;
    }
    __syncthreads();
    const XcdBarrier xbar = xcd_barrier_post(barw, MISC + 8);
#define GRID_BAR() xcd_barrier(xbar)
    {
        FRESH_IDS();
        LAS float* scr = (LAS float*)(lds + wave * 16384);
        constexpr int I_A = 16 * 64, I_B = 16 * 72, I_G = 16 * 96, I_P = 8 * 32, I_O = 16 * 32, I_UP = 16 * 176, I_DN = 44 * 32;
        constexpr int I_LAYER = I_A + I_B + I_G + 3 * I_P + I_O + I_UP + I_DN;
        for (int it = gw; it < 2 * I_LAYER; it += NGW) {
            const int l = it / I_LAYER; int r = it - l * I_LAYER;
            bf16_t* WL = Wb + (size_t)l * LAYER_W;
            const float* w_in = args.in[2] + (size_t)l * DM * DIN;
            if (r < I_A) { transpose_item(w_in, DIN, 2048, WL + OW_IN, DM, 0, scr, r, lane, args.in[1] + l * DM); continue; } r -= I_A;
            if (r < I_B) { transpose_item(w_in + 2064, DIN, 2304, WL + OW_IN, DM, 2048, scr, r, lane, args.in[1] + l * DM); continue; } r -= I_B;
            if (r < I_G) { transpose_item(w_in + 4368, DIN, 3072, WL + OW_G, DM, 0, scr, r, lane, args.in[1] + l * DM); continue; } r -= I_G;
            if (r < I_P) { transpose_item(args.in[8] + (size_t)l * 512 * DM, DM, DM, WL + OW_GLA, 512, 0, scr, r, lane); continue; } r -= I_P;
            if (r < I_P) { transpose_item(args.in[9] + (size_t)l * 512 * DM, DM, DM, WL + OW_CONV, 512, 0, scr, r, lane); continue; } r -= I_P;
            if (r < I_P) { transpose_item(args.in[10] + (size_t)l * 512 * DM, DM, DM, WL + OW_SWA, 512, 0, scr, r, lane); continue; } r -= I_P;
            if (r < I_O) { transpose_item(args.in[11] + (size_t)l * DM * DM, DM, DM, WL + OW_O, DM, 0, scr, r, lane); continue; } r -= I_O;
            if (r < I_UP) { transpose_item<true>(args.in[13] + (size_t)l * DM * DFF2, DFF2, DFF2, WL + OW_UP, DM, 0, scr, r, lane, args.in[12] + l * DM); continue; } r -= I_UP;
            transpose_item(args.in[15] + (size_t)l * DFF * DM, DM, DM, WL + OW_DN, DFF, 0, scr, r, lane);
        }
        for (int idx = blk * NTHREADS + tid; idx < 2 * 256 * DM; idx += G * NTHREADS) {
            const int l = idx / (256 * DM), rem = idx - l * 256 * DM, row = rem >> 10, k = rem & 1023;
            const float v = row < 16 ? args.in[2][(size_t)l * DM * DIN + (size_t)k * DIN + 2048 + row] * args.in[1][l * DM + k] : 0.f;
            Wb[(size_t)l * LAYER_W + OW_IN + (size_t)(4352 + row) * DM + k] = (bf16_t)f2bf(v);
        }
        for (int m = gw; m < T; m += 4 * NGW) {
            f32x4 v[4][4]; float sq[4];
#pragma unroll
            for (int h4 = 0; h4 < 4; ++h4) { const int mm = m + h4 * NGW; const f32x4* xr = (const f32x4*)(x + (size_t)(mm < T ? mm : m) * DM) + lane;
#pragma unroll
                for (int j = 0; j < 4; ++j) v[h4][j] = xr[64 * j]; }
#pragma unroll
            for (int h4 = 0; h4 < 4; ++h4) { float q = 0.f;
#pragma unroll
                for (int j = 0; j < 4; ++j) q += (v[h4][j].x * v[h4][j].x + v[h4][j].y * v[h4][j].y) + (v[h4][j].z * v[h4][j].z + v[h4][j].w * v[h4][j].w);
                sq[h4] = q; }
#pragma unroll
            for (int o = 1; o < 64; o <<= 1) {
#pragma unroll
                for (int h4 = 0; h4 < 4; ++h4) sq[h4] += __shfl_xor(sq[h4], o); }
#pragma unroll
            for (int h4 = 0; h4 < 4; ++h4) { const int mm = m + h4 * NGW; if (mm < T) {
                unsigned long long* o8 = (unsigned long long*)(U + (size_t)mm * DM) + lane;
#pragma unroll
                for (int j = 0; j < 4; ++j) o8[64 * j] = (unsigned long long)pk2(v[h4][j].x, v[h4][j].y) | ((unsigned long long)pk2(v[h4][j].z, v[h4][j].w) << 32);
                if (lane < 4) *(f32x4*)(SSQ + ((size_t)lane * T + mm) * 4) = (f32x4){lane == 0 ? sq[h4] : 0.f, 0.f, 0.f, 0.f}; } }
        }
    }
    GRID_BAR();
    if (G == 0x7fffffff) grid.sync();

    for (int l = 0; l < 2; ++l) {
        const bf16_t* WL = Wb + (size_t)l * LAYER_W;
        {
            pg8::Gemm g{U, U, U, WL + OW_IN, WL + OW_IN, WL + OW_IN};
            pg8::StaticOrder<1, ZLD> S; S.init(G, blk);
            pg8::EpiBf16<0> E{Z, ZLD, SSQ};
            if (PHM & 16) pg8::gemm_phase<pg8::EpiBf16<0>, pg8::StaticOrder<1, ZLD>, 1, DM, DM, DM>(lds, g, S, E);
        }
        GRID_BAR();
        {
            float* Sbuf = (float*)(args.ws + WS_SBUF); float* Btot = (float*)(args.ws + WS_BTOT);
            if (PHM & 1) for (int u = blk; u < 256; u += G) gla_segment<false>(lds, Z, args.in[3] + (size_t)l * 16 * 512, args.in[4] + (size_t)l * 512, args.in[5] + (size_t)l * 512, u, Sbuf, Btot);
            for (int u = blk; u < NB * 32 * 2; u += G) { const int kvh = u & 1, qb = (u >> 1) & 31, b = u >> 6; if (PHM & 2) swa_unit(lds, Z, args.in[7] + l * 8, b, qb, kvh); }
        }
        GRID_BAR();
        {
            float* Sbuf = (float*)(args.ws + WS_SBUF); float* Btot = (float*)(args.ws + WS_BTOT);
            if (PHM & 1) for (int u = blk; u < 256; u += G) gla_segment<true>(lds, Z, args.in[3] + (size_t)l * 16 * 512, args.in[4] + (size_t)l * 512, args.in[5] + (size_t)l * 512, u, Sbuf, Btot);
            FRESH_IDS();
            const float* cw = args.in[6] + (size_t)l * 3 * 512;
            if (PHM & 4) for (int it = blk * NTHREADS + tid; it < (T / 4) * 64; it += G * NTHREADS) {
                const int tg = it >> 6, c8 = it & 63, t0 = tg * 4; const bool has_prev = (t0 & (SEQ - 1)) != 0;
                bf16_t* zp = Z + (size_t)t0 * ZLD + c8 * 8;
                const u32x4 z4 = (u32x4){0u, 0u, 0u, 0u};
                u32x4 xm2 = z4, cm2 = z4, xm1 = z4, cm1 = z4, xr[4], cr[4], br[4];
                if (has_prev) { xm2 = *(const u32x4*)(zp - 2 * ZLD + ZCX); cm2 = *(const u32x4*)(zp - 2 * ZLD + ZCC); xm1 = *(const u32x4*)(zp - ZLD + ZCX); cm1 = *(const u32x4*)(zp - ZLD + ZCC); }
#pragma unroll
                for (int q = 0; q < 4; ++q) { xr[q] = *(const u32x4*)(zp + (size_t)q * ZLD + ZCX); cr[q] = *(const u32x4*)(zp + (size_t)q * ZLD + ZCC); br[q] = *(const u32x4*)(zp + (size_t)q * ZLD + ZCB); }
                float w0[8], w1[8], w2[8], p2[8], p1[8];
#pragma unroll
                for (int e = 0; e < 8; ++e) { w0[e] = cw[c8 * 8 + e]; w1[e] = cw[512 + c8 * 8 + e]; w2[e] = cw[1024 + c8 * 8 + e]; }
#pragma unroll
                for (int e = 0; e < 4; ++e) { p2[2 * e] = bflo(xm2[e]) * bflo(cm2[e]); p2[2 * e + 1] = bfhi(xm2[e]) * bfhi(cm2[e]); p1[2 * e] = bflo(xm1[e]) * bflo(cm1[e]); p1[2 * e + 1] = bfhi(xm1[e]) * bfhi(cm1[e]); }
#pragma unroll
                for (int q = 0; q < 4; ++q) { float p0[8]; unsigned res[4];
#pragma unroll
                    for (int e = 0; e < 4; ++e) { p0[2 * e] = bflo(xr[q][e]) * bflo(cr[q][e]); p0[2 * e + 1] = bfhi(xr[q][e]) * bfhi(cr[q][e]); }
#pragma unroll
                    for (int e = 0; e < 4; ++e) {
                        const float lo = bflo(br[q][e]) * (w0[2 * e] * p2[2 * e] + w1[2 * e] * p1[2 * e] + w2[2 * e] * p0[2 * e]);
                        const float hi = bfhi(br[q][e]) * (w0[2 * e + 1] * p2[2 * e + 1] + w1[2 * e + 1] * p1[2 * e + 1] + w2[2 * e + 1] * p0[2 * e + 1]);
                        res[e] = pk2(lo, hi); }
                    *(u32x4*)(zp + (size_t)q * ZLD + ZCB) = (u32x4){res[0], res[1], res[2], res[3]};
#pragma unroll
                    for (int e = 0; e < 8; ++e) { p2[e] = p1[e]; p1[e] = p0[e]; } }
            }
        }
        GRID_BAR();
        {
            pg8::Gemm g{U, U, U, WL + OW_G, WL + OW_G, WL + OW_G};
            pg8::StaticOrder<1, 3072> S; S.init(G, blk);
            pg8::EpiBf16<1> E{Z, ZLD, SSQ};
            if (PHM & 32) pg8::gemm_phase<pg8::EpiBf16<1>, pg8::StaticOrder<1, 3072>, 1, DM, DM, DM>(lds, g, S, E);
        }
        GRID_BAR();
        {
            pg8::Gemm g{Z + ZR, Z + ZCB, Z + ZSQ, WL + OW_GLA, WL + OW_CONV, WL + OW_SWA};
            pg8::StaticOrder<3, DM> S; S.init(G, blk);
            pg8::EpiMerge E{Z, MRG, DM};
            if (PHM & 64) pg8::gemm_phase<pg8::EpiMerge, pg8::StaticOrder<3, DM>, 3, 512, ZLD, 512>(lds, g, S, E);
        }
        GRID_BAR();
        {
            pg8::Gemm g{MRG, MRG, MRG, WL + OW_O, WL + OW_O, WL + OW_O};
            pg8::StaticOrder<1, DM> S; S.init(G, blk);
            pg8::EpiResid E{(const float*)nullptr, U, (float*)nullptr, DM, U, SSQ};
            if (PHM & 128) pg8::gemm_phase<pg8::EpiResid, pg8::StaticOrder<1, DM>, 1, DM, DM, DM>(lds, g, S, E);
        }
        GRID_BAR();
        {
            pg8::Gemm g{U, U, U, WL + OW_UP, WL + OW_UP, WL + OW_UP};
            pg8::StaticOrder<1, DFF2> S; S.init(G, blk);
            pg8::EpiAct E{ACT, PRE, args.in[14] + (size_t)l * 3 * DFF2, lds + 131072, SSQ};
            if (PHM & 16) pg8::gemm_phase<pg8::EpiAct, pg8::StaticOrder<1, DFF2>, 1, DM, DM, DM>(lds, g, S, E);
        }
        GRID_BAR();
        {
            pg8::Gemm g{ACT, ACT, ACT, WL + OW_DN, WL + OW_DN, WL + OW_DN};
            pg8::StaticOrder<1, DM> S; S.init(G, blk);
            {
                FRESH_IDS();
                const float* fw = args.in[14] + (size_t)l * 3 * DFF2;
                pg8::Unit fu;
                for (int i = 0; S.next(i, fu); ++i) {
                    const int pm = fu.pm; const bool first = (pm & 15) == 0;
                    const float* P0 = PRE + (size_t)pm * 4 * DFF2; const float* Pp = PRE + (size_t)(pm - 1) * 4 * DFF2;
                    float fx0[6][2], fx1[6][2], fm2[6][2], fm1[6][2], fw0[6][2], fw1[6][2], fw2[6][2];
#pragma unroll
                    for (int k = 0; k < 6; ++k) { const int c = tid + k * NTHREADS;
#pragma unroll
                        for (int hbj = 0; hbj < 2; ++hbj) { const int cc = (c < DFF ? c : tid) + hbj * DFF;
                            fx0[k][hbj] = P0[cc]; fx1[k][hbj] = P0[DFF2 + cc]; fm2[k][hbj] = first ? 0.f : Pp[2 * DFF2 + cc]; fm1[k][hbj] = first ? 0.f : Pp[3 * DFF2 + cc];
                            fw0[k][hbj] = fw[cc]; fw1[k][hbj] = fw[DFF2 + cc]; fw2[k][hbj] = fw[2 * DFF2 + cc]; } }
#pragma unroll
                    for (int k = 0; k < 6; ++k) { const int c = tid + k * NTHREADS;
                        if (c < DFF) {
                            const float ra0 = fw0[k][0] * fm2[k][0] + fw1[k][0] * fm1[k][0] + fw2[k][0] * fx0[k][0], ra1 = fw0[k][0] * fm1[k][0] + fw1[k][0] * fx0[k][0] + fw2[k][0] * fx1[k][0];
                            const float rb0 = fw0[k][1] * fm2[k][1] + fw1[k][1] * fm1[k][1] + fw2[k][1] * fx0[k][1], rb1 = fw0[k][1] * fm1[k][1] + fw1[k][1] * fx0[k][1] + fw2[k][1] * fx1[k][1];
                            ACT[(size_t)(pm * 256) * DFF + c] = (bf16_t)f2bf(siluf_(ra0) * rb0);
                            ACT[(size_t)(pm * 256 + 1) * DFF + c] = (bf16_t)f2bf(siluf_(ra1) * rb1); } }
                }
                __threadfence();
                asm volatile("s_waitcnt vmcnt(0)" ::: "memory");
                __syncthreads();
                __builtin_amdgcn_fence(__ATOMIC_ACQUIRE, "agent");
            }
            pg8::EpiResid E{(const float*)nullptr, U, (float*)nullptr, DM, U, SSQ};
            if (PHM & 128) pg8::gemm_phase<pg8::EpiResid, pg8::StaticOrder<1, DM>, 1, DFF, DFF, DFF>(lds, g, S, E);
        }
        GRID_BAR();
    }
    { FRESH_IDS();
      const f32x4* gr = (const f32x4*)args.in[16] + lane;
      for (int m = gw; m < T; m += 4 * NGW) {
          u32x2 v[4][4]; f32x4 pq[4][4];
#pragma unroll
          for (int h4 = 0; h4 < 4; ++h4) { const int mm = (m + h4 * NGW) < T ? (m + h4 * NGW) : m; const u32x2* hr = (const u32x2*)(U + (size_t)mm * DM) + lane;
#pragma unroll
              for (int j = 0; j < 4; ++j) { v[h4][j] = hr[64 * j]; pq[h4][j] = *(const f32x4*)(SSQ + ((size_t)j * T + mm) * 4); } }
#pragma unroll
          for (int h4 = 0; h4 < 4; ++h4) { const int mm = m + h4 * NGW; if (mm < T) {
              float sq = 0.f;
#pragma unroll
              for (int j = 0; j < 4; ++j) sq += (pq[h4][j].x + pq[h4][j].y) + (pq[h4][j].z + pq[h4][j].w);
              const float rstd = __builtin_amdgcn_rsqf(sq * (1.f / DM) + EPS); f32x4* xw = (f32x4*)(out + (size_t)mm * DM) + lane;
#pragma unroll
              for (int j = 0; j < 4; ++j) { const f32x4 hv = (f32x4){bflo(v[h4][j].x), bfhi(v[h4][j].x), bflo(v[h4][j].y), bfhi(v[h4][j].y)}; xw[64 * j] = hv * rstd * gr[64 * j]; } } }
      }
    }
}

extern "C" void kernel_launch(void* const* d_in, const int* in_sizes, int n_in, void* d_out, int out_size, void* d_ws, size_t ws_size, hipStream_t stream) {
    static int grid_blocks = 0;
    if (grid_blocks == 0) {
        if (n_in != 17 || out_size != T * DM || ws_size < WS_END) { fprintf(stderr, "kernel_launch: unexpected shapes (n_in %d out %d ws %zu)\n", n_in, out_size, ws_size); grid_blocks = -1; return; }
        int dev = 0, cus = 0, per_cu = 0;
        hipGetDevice(&dev);
        hipDeviceGetAttribute(&cus, hipDeviceAttributeMultiprocessorCount, dev);
        if (hipFuncSetAttribute((const void*)mega_fwd, hipFuncAttributeMaxDynamicSharedMemorySize, LDS_BYTES) != hipSuccess) { fprintf(stderr, "kernel_launch: hipFuncSetAttribute failed\n"); grid_blocks = -1; return; }
        if (hipOccupancyMaxActiveBlocksPerMultiprocessor(&per_cu, (const void*)mega_fwd, NTHREADS, LDS_BYTES) != hipSuccess || per_cu < 1) { fprintf(stderr, "kernel_launch: occupancy query says %d\n", per_cu); per_cu = 1; }
        (void)hipGetLastError();
        grid_blocks = cus * (per_cu > 1 ? 1 : per_cu);
        fprintf(stderr, "kernel_launch: grid %d (cus %d, per_cu %d), ws %zu\n", grid_blocks, cus, per_cu, ws_size);
    }
    if (grid_blocks < 0) return;
    Args a{};
    for (int i = 0; i < 17; ++i) a.in[i] = (const float*)d_in[i];
    a.out = (float*)d_out; a.ws = (unsigned char*)d_ws;
    void* kargs[] = {&a};
    if (hipMemsetAsync((unsigned char*)d_ws + WS_BAR, 0, XCD_BAR_WORDS * 4, stream) != hipSuccess) { fprintf(stderr, "kernel_launch: memset of the barrier words failed\n"); return; }
    hipError_t e = hipLaunchCooperativeKernel((const void*)mega_fwd, dim3(grid_blocks), dim3(NTHREADS), kargs, LDS_BYTES, stream);
    if (e != hipSuccess) fprintf(stderr, "kernel_launch: cooperative launch failed: %s (grid %d)\n", hipGetErrorString(e), grid_blocks);
}
```

```cpp
#include <hip/hip_runtime.h>
#include <hip/hip_cooperative_groups.h>
#include <cstdio>
#include <cstdint>
#include <cmath>
namespace cg = cooperative_groups;

#define LAS __attribute__((address_space(3)))
typedef unsigned short bf16_t;
typedef short bf16x8 __attribute__((ext_vector_type(8)));
typedef float f32x4 __attribute__((ext_vector_type(4)));
typedef float f32x2 __attribute__((ext_vector_type(2)));
typedef unsigned u32x4 __attribute__((ext_vector_type(4)));
typedef unsigned u32x2 __attribute__((ext_vector_type(2)));

constexpr int NB = 8, SEQ = 4096, T = NB * SEQ, DM = 1024, DIN = 7440, DFF = 2816, DFF2 = 5632;
constexpr int ZLD = 4608;
constexpr int ZQ = 0, ZK = 512, ZV = 1024, ZR = 1536, ZCX = 2048, ZCB = 2560, ZCC = 3072, ZSQ = 3584, ZSK = 4096, ZSV = 4224, ZGA = 4352;
constexpr float EPS = 1e-6f;
constexpr size_t OW_IN = 0, OW_G = 4718592, OW_GLA = 7864320, OW_CONV = 8388608, OW_SWA = 8912896, OW_O = 9437184, OW_UP = 10485760, OW_DN = 16252928, LAYER_W = 19136512;
constexpr size_t MiB = 1u << 20;
constexpr size_t WS_W = 0, WS_BTOT = 76 * MiB, WS_BAR = 77 * MiB, WS_SSQ = 78 * MiB, WS_U = 80 * MiB, WS_BIG = 144 * MiB, WS_SBUF = 496 * MiB, WS_END = 512 * MiB;
static_assert(2 * LAYER_W * 2 <= WS_BTOT, "weights fit");
constexpr int LDS_BYTES = 147456;
constexpr int NTHREADS = 512;
#ifndef PHM
#define PHM 0xffff
#endif

__device__ __forceinline__ unsigned f2bf(float f) { unsigned u = __builtin_bit_cast(unsigned, f); return (u + 0x7fffu + ((u >> 16) & 1u)) >> 16; }
__device__ __forceinline__ unsigned pk2(float lo, float hi) { return f2bf(lo) | (f2bf(hi) << 16); }
__device__ __forceinline__ float bf2f(bf16_t h) { return __builtin_bit_cast(float, (unsigned)h << 16); }
__device__ __forceinline__ float bflo(unsigned w) { return __builtin_bit_cast(float, w << 16); }
__device__ __forceinline__ float bfhi(unsigned w) { return __builtin_bit_cast(float, w & 0xffff0000u); }
__device__ __forceinline__ unsigned cvt_pk_bf16(float lo, float hi) { unsigned r; asm volatile("s_nop 1\n\tv_cvt_pk_bf16_f32 %0, %1, %2" : "=v"(r) : "v"(lo), "v"(hi)); return r; }
__device__ __forceinline__ unsigned hwbf(float f) { return cvt_pk_bf16(f, 0.f) & 0xffffu; }
__device__ __forceinline__ float wave_sum(float v) {
#pragma unroll
    for (int o = 1; o < 64; o <<= 1) v += __shfl_xor(v, o);
    return v;
}
__device__ __forceinline__ float sigmoidf_(float x) { return __builtin_amdgcn_rcpf(1.0f + __expf(-x)); }
__device__ __forceinline__ float siluf_(float x) { return x * __builtin_amdgcn_rcpf(1.0f + __expf(-x)); }
#define LDS_WAIT() asm volatile("s_waitcnt lgkmcnt(0)" ::: "memory")
__device__ __forceinline__ int fresh_tid() { int t = threadIdx.x; asm volatile("" : "+v"(t)); return t; }

namespace pg8 {
constexpr int BM = 256, BK = 64, HALF = 128, HTB = HALF * BK * 2, STAGE_BYTES = 8 * HTB, NXCD = 8, WGM = 8;
__host__ __device__ __forceinline__ int lds_byte(int r, int c) { const int st = (r >> 4) * 2 + (c >> 5), rr = r & 15, cc = c & 31, ob = rr * 64 + cc * 2; return st * 1024 + (ob ^ (((ob >> 9) & 1) << 5)); }
__host__ __device__ __forceinline__ void stage_rc(int b, int& R, int& C) { const int st = b / 1024, sb = b % 1024, swz = sb ^ (((sb >> 9) & 1) << 5); R = (st >> 1) * 16 + swz / 64; C = (st & 1) * 32 + (swz % 64) / 2; }
__host__ __device__ __forceinline__ int perm32(int rho) { const int n = rho >> 4, i = rho & 15; return 8 * (i >> 2) + 4 * n + (i & 3); }

struct Unit { int pm, pn, seg; };
struct Gemm { const bf16_t* A0; const bf16_t* A1; const bf16_t* A2; const bf16_t* B0; const bf16_t* B1; const bf16_t* B2; };

template <int NSEG, int N_> struct StaticOrder {
    static constexpr int nM = T / BM, nN = N_ / BM, nwg = nM * nN;
    int G, c;
    __device__ __forceinline__ void init(int G_, int c_) { G = G_; c = c_; }
    __device__ __forceinline__ bool next(int i, Unit& u) const {
        const int ti = (NSEG == 1) ? i : i / NSEG; u.seg = (NSEG == 1) ? 0 : i - ti * NSEG;
        const long L = (long)ti * G + c; if (L >= nwg) return false;
        int wgid = (int)L; { const int q = nwg / NXCD, r = nwg % NXCD, xcd = wgid % NXCD, off = wgid / NXCD; wgid = (xcd < r ? xcd * (q + 1) : r * (q + 1) + (xcd - r) * q) + off; }
        const int nig = WGM * nN, gid = wgid / nig, fm = gid * WGM, gsz = (nM - fm) < WGM ? (nM - fm) : WGM;
        u.pm = fm + ((wgid % nig) % gsz); u.pn = (wgid % nig) / gsz; return true;
    }
};


__device__ __forceinline__ void scale_rows(f32x4 (&acc)[2][2][4][2], const float* ssq, const Unit& u, int wr, int fr, int fq, float mul = 1.0f) {
    f32x4 p[2][4];
#pragma unroll
    for (int ai = 0; ai < 2; ++ai)
#pragma unroll
        for (int m = 0; m < 4; ++m) { const size_t r = (size_t)(u.pm * BM + ai * HALF + wr * 64 + m * 16 + fr); p[ai][m] = *(const f32x4*)(ssq + ((size_t)fq * T + r) * 4); }
#pragma unroll
    for (int ai = 0; ai < 2; ++ai)
#pragma unroll
        for (int m = 0; m < 4; ++m) { float sq = (p[ai][m].x + p[ai][m].y) + (p[ai][m].z + p[ai][m].w);
            sq += __shfl_xor(sq, 16); sq += __shfl_xor(sq, 32);
            const float rs = __builtin_amdgcn_rsqf(sq * (1.0f / DM) + EPS) * mul;
#pragma unroll
            for (int bj = 0; bj < 2; ++bj)
#pragma unroll
                for (int n = 0; n < 2; ++n) acc[ai][bj][m][n] = acc[ai][bj][m][n] * rs; }
}

template <int MODE  > struct EpiBf16 {
    static constexpr bool PERM = true;
    bf16_t* O; int ldc; const float* ssq;
    __device__ __forceinline__ bool keep(const Unit&) const { return false; }
    __device__ __forceinline__ static int gate_zcol(int tile) {
        return tile < 4 ? tile * 256 : tile < 6 ? 1024 + (tile - 4) * 256 : tile < 8 ? ZCX + (tile - 6) * 256 : tile < 10 ? ZCC + (tile - 8) * 256 : tile == 10 ? ZSK : ZGA;
    }
    __device__ __forceinline__ void operator()(f32x4 (&acc)[2][2][4][2], const Unit& u, int wr, int wc, int fr, int fq) const {
        scale_rows(acc, ssq, u, wr, fr, fq, MODE == 1 ? -1.4426950408889634f : 1.0f);
        const int row0 = u.pm * BM + wr * 64 + fr;
        const int colt = (MODE == 1) ? gate_zcol(u.pn) : u.pn * BM;
        const int col0 = colt + wc * 32 + 8 * fq;
#pragma unroll
        for (int ai = 0; ai < 2; ++ai)
#pragma unroll
            for (int m = 0; m < 4; ++m) { bf16_t* rowp = O + (size_t)(row0 + ai * HALF + m * 16) * ldc + col0;
#pragma unroll
                for (int bj = 0; bj < 2; ++bj) { f32x4 v0 = acc[ai][bj][m][0], v1 = acc[ai][bj][m][1];
                    if (MODE == 1) {
                        unsigned g0 = 0u, g1 = 0u;
#pragma unroll
                        for (int e = 0; e < 4; ++e) { g0 = __builtin_amdgcn_cvt_pk_u8_f32(fmaxf(floorf(255.f * __builtin_amdgcn_rcpf(1.0f + __builtin_amdgcn_exp2f(v0[e])) + 0.5f), 1.f), e, g0);
                                                      g1 = __builtin_amdgcn_cvt_pk_u8_f32(fmaxf(floorf(255.f * __builtin_amdgcn_rcpf(1.0f + __builtin_amdgcn_exp2f(v1[e])) + 0.5f), 1.f), e, g1); }
                        *(u32x2*)((unsigned char*)O + ((size_t)(row0 + ai * HALF + m * 16) * ldc + colt) * 2 + bj * HALF + wc * 32 + 8 * fq) = (u32x2){g0, g1};
                    } else {
                    if (u.pn * BM + bj * HALF + wc * 32 + 8 * fq < ZGA + 16) {
                    u32x4 w; w.x = cvt_pk_bf16(v0[0], v0[1]); w.y = cvt_pk_bf16(v0[2], v0[3]); w.z = cvt_pk_bf16(v1[0], v1[1]); w.w = cvt_pk_bf16(v1[2], v1[3]);
                    *(u32x4*)(rowp + bj * HALF) = w; } } } }
    }
};

struct EpiMerge {
    static constexpr bool PERM = true;
    const bf16_t* Zg; bf16_t* O; int ldc;
    __device__ __forceinline__ bool keep(const Unit& u) const { return u.seg != 2; }
    __device__ __forceinline__ void operator()(f32x4 (&acc)[2][2][4][2], const Unit& u, int wr, int wc, int fr, int fq) const {
        const int row0 = u.pm * BM + wr * 64 + fr;
        const int seg = u.seg;
        const int gnum = EpiBf16<1>::gate_zcol(4 * seg + u.pn) * 2 + wc * 32 + 8 * fq;
        const int gden = EpiBf16<1>::gate_zcol(4 * (seg < 2 ? seg + 1 : 2) + u.pn) * 2 + wc * 32 + 8 * fq;
        const int col0 = u.pn * BM + wc * 32 + 8 * fq;
        const unsigned char* Zb = (const unsigned char*)Zg;
        u32x2 gnv[2][4][2], gdv[2][4][2];
#pragma unroll
        for (int ai = 0; ai < 2; ++ai)
#pragma unroll
            for (int m = 0; m < 4; ++m) { const size_t r = (size_t)(row0 + ai * HALF + m * 16);
#pragma unroll
                for (int bj = 0; bj < 2; ++bj) { gnv[ai][m][bj] = *(const u32x2*)(Zb + r * (ZLD * 2) + gnum + bj * HALF);
                    gdv[ai][m][bj] = (seg < 2) ? *(const u32x2*)(Zb + r * (ZLD * 2) + gden + bj * HALF) : (u32x2){0u, 0u}; } }
#pragma unroll
        for (int ai = 0; ai < 2; ++ai) {
#pragma unroll
            for (int m = 0; m < 4; ++m) { const size_t r = (size_t)(row0 + ai * HALF + m * 16);
#pragma unroll
                for (int bj = 0; bj < 2; ++bj) {
                    const u32x2 gn = gnv[ai][m][bj], gd = gdv[ai][m][bj];
                    float f[8];
#pragma unroll
                    for (int e = 0; e < 4; ++e) { f[e] = (float)((gn.x >> (8 * e)) & 0xffu); f[4 + e] = (float)((gn.y >> (8 * e)) & 0xffu); }
                    if (seg < 2) {
#pragma unroll
                        for (int e = 0; e < 4; ++e) { f[e] = f[e] * __builtin_amdgcn_rcpf((float)((gd.x >> (8 * e)) & 0xffu)); f[4 + e] = f[4 + e] * __builtin_amdgcn_rcpf((float)((gd.y >> (8 * e)) & 0xffu)); }
                    } else {
#pragma unroll
                        for (int e = 0; e < 8; ++e) f[e] = f[e] * (1.0f / 255.0f);
                    }
                    f32x4 v0 = acc[ai][bj][m][0], v1 = acc[ai][bj][m][1];
#pragma unroll
                    for (int e = 0; e < 4; ++e) { v0[e] *= f[e]; v1[e] *= f[4 + e]; }
                    acc[ai][bj][m][0] = v0; acc[ai][bj][m][1] = v1;
                    if (seg == 2) {
                        u32x4 w; w.x = cvt_pk_bf16(v0[0], v0[1]); w.y = cvt_pk_bf16(v0[2], v0[3]); w.z = cvt_pk_bf16(v1[0], v1[1]); w.w = cvt_pk_bf16(v1[2], v1[3]);
                        *(u32x4*)(O + r * ldc + col0 + bj * HALF) = w;
                    }
                } }
        }
    }
};

#define DPPF(v, ctrl) __builtin_bit_cast(float, __builtin_amdgcn_update_dpp(0, __builtin_bit_cast(int, (v)), (ctrl), 0xf, 0xf, true))
struct EpiAct {
    static constexpr bool PERM = true;
    bf16_t* ACT; float* PRE; const float* fw; LAS unsigned char* xch; const float* ssq;
    __device__ __forceinline__ bool keep(const Unit&) const { return false; }
    __device__ __forceinline__ void operator()(f32x4 (&acc)[2][2][4][2], const Unit& u, int wr, int wc, int fr, int fq) const {
        LAS float* X = (LAS float*)xch;
        const int chb = u.pn * 128 + wc * 32 + 8 * fq;
        f32x4 wq[3][2];
#pragma unroll
        for (int k = 0; k < 3; ++k)
#pragma unroll
            for (int bj = 0; bj < 2; ++bj) wq[k][bj] = *(const f32x4*)(fw + k * DFF2 + bj * DFF + chb);
        {
            LAS float* RS = X + 2048;
            const int lane_e = fq * 16 + fr;
            if (lane_e < 32) { const int rr = (wr * 4 + wc) * 32 + lane_e; const float* sp = ssq + (size_t)(u.pm * BM + rr) * 4;
                const f32x4 a0 = *(const f32x4*)sp, a1 = *(const f32x4*)(sp + (size_t)T * 4), a2 = *(const f32x4*)(sp + (size_t)T * 8), a3 = *(const f32x4*)(sp + (size_t)T * 12);
                const float sq = ((a0.x + a0.y) + (a0.z + a0.w)) + ((a1.x + a1.y) + (a1.z + a1.w)) + ((a2.x + a2.y) + (a2.z + a2.w)) + ((a3.x + a3.y) + (a3.z + a3.w));
                RS[rr] = __builtin_amdgcn_rsqf(sq * (1.0f / DM) + EPS); }
            asm volatile("s_waitcnt lgkmcnt(0)" ::: "memory"); __builtin_amdgcn_s_barrier(); asm volatile("" ::: "memory");
#pragma unroll
            for (int ai = 0; ai < 2; ++ai)
#pragma unroll
                for (int m = 0; m < 4; ++m) { const float rs = RS[ai * HALF + wr * 64 + m * 16 + fr];
#pragma unroll
                    for (int bj = 0; bj < 2; ++bj)
#pragma unroll
                        for (int n = 0; n < 2; ++n) acc[ai][bj][m][n] = acc[ai][bj][m][n] * rs; }
        }
        if (fr >= 14) {
#pragma unroll
            for (int ai = 0; ai < 2; ++ai) { LAS float* p = X + ((((ai * 2 + wr) * 4 + wc) * 2 + (fr - 14)) * 4 + fq) * 16;
#pragma unroll
                for (int bj = 0; bj < 2; ++bj)
#pragma unroll
                    for (int n = 0; n < 2; ++n) *(LAS f32x4*)(p + bj * 8 + n * 4) = acc[ai][bj][3][n]; }
            if (wr == 1) { float* q = PRE + ((size_t)u.pm * 4 + 2 + (fr - 14)) * DFF2 + chb;
#pragma unroll
                for (int bj = 0; bj < 2; ++bj)
#pragma unroll
                    for (int n = 0; n < 2; ++n) *(f32x4*)(q + bj * DFF + 4 * n) = acc[1][bj][3][n]; }
        }
        if (wr == 0 && fr < 2) { float* q = PRE + ((size_t)u.pm * 4 + fr) * DFF2 + chb;
#pragma unroll
            for (int bj = 0; bj < 2; ++bj)
#pragma unroll
                for (int n = 0; n < 2; ++n) *(f32x4*)(q + bj * DFF + 4 * n) = acc[0][bj][0][n]; }
        asm volatile("s_waitcnt lgkmcnt(0)" ::: "memory"); __builtin_amdgcn_s_barrier(); asm volatile("" ::: "memory");
#pragma unroll
        for (int n = 0; n < 2; ++n) {
            f32x4 w[3][2];
#pragma unroll
            for (int k = 0; k < 3; ++k)
#pragma unroll
                for (int bj = 0; bj < 2; ++bj) w[k][bj] = (n == 0) ? wq[k][bj] : *(const f32x4*)(fw + k * DFF2 + bj * DFF + chb + 4);
#pragma unroll
            for (int ai = 0; ai < 2; ++ai)
#pragma unroll
                for (int m = 0; m < 4; ++m) {
                    f32x4 t1[2], t2[2];
                    if (m > 0) {
#pragma unroll
                        for (int bj = 0; bj < 2; ++bj)
#pragma unroll
                            for (int e = 0; e < 4; ++e) { const float pv = acc[ai][bj][m - 1][n][e]; t1[bj][e] = DPPF(pv, 0x10F); t2[bj][e] = DPPF(pv, 0x10E); }
                    } else {
                        const bool has_pred = (wr == 1) || (ai == 1);
                        const int pai = (wr == 1) ? ai : 0, pwr = (wr == 1) ? 0 : 1;
                        const LAS float* p14 = X + ((((pai * 2 + pwr) * 4 + wc) * 2 + 0) * 4 + fq) * 16; const LAS float* p15 = p14 + 64;
#pragma unroll
                        for (int bj = 0; bj < 2; ++bj) { const f32x4 r14 = *(const LAS f32x4*)(p14 + bj * 8 + n * 4), r15 = *(const LAS f32x4*)(p15 + bj * 8 + n * 4);
#pragma unroll
                            for (int e = 0; e < 4; ++e) { t1[bj][e] = (has_pred && fr == 0) ? r15[e] : 0.f; t2[bj][e] = has_pred ? (fr == 0 ? r14[e] : (fr == 1 ? r15[e] : 0.f)) : 0.f; } }
                    }
                    float h[2][4];
#pragma unroll
                    for (int bj = 0; bj < 2; ++bj)
#pragma unroll
                        for (int e = 0; e < 4; ++e) { const float cur = acc[ai][bj][m][n][e];
                            const float p1 = DPPF(cur, 0x111) + t1[bj][e], p2 = DPPF(cur, 0x112) + t2[bj][e];
                            h[bj][e] = w[0][bj][e] * p2 + w[1][bj][e] * p1 + w[2][bj][e] * cur; }
                    float r4[4];
#pragma unroll
                    for (int c = 0; c < 4; ++c) r4[c] = siluf_(h[0][c]) * h[1][c];
                    const bool skip = (ai == 0) && (m == 0) && (wr == 0) && (fr < 2);
                    if (!skip) { u32x2 o; o.x = cvt_pk_bf16(r4[0], r4[1]); o.y = cvt_pk_bf16(r4[2], r4[3]);
                        *(u32x2*)(ACT + (size_t)(u.pm * BM + ai * HALF + wr * 64 + m * 16 + fr) * DFF + chb + 4 * n) = o; }
                }
            asm volatile("" ::: "memory");
        }
    }
};

struct EpiResid {
    static constexpr bool PERM = false;
    const float* basef; const bf16_t* baseb; float* out; int ldc; bf16_t* hb; float* ssq;
    __device__ __forceinline__ bool keep(const Unit&) const { return false; }
    __device__ __forceinline__ void operator()(f32x4 (&acc)[2][2][4][2], const Unit& u, int wr, int wc, int fr, int fq) const {
        const int col0 = u.pn * BM + wc * 32 + 4 * fq;
#pragma unroll
        for (int ai = 0; ai < 2; ++ai) {
            u32x2 bb[4][2][2];
            if (!basef) {
#pragma unroll
                for (int m = 0; m < 4; ++m) { const size_t off = (size_t)(u.pm * BM + ai * HALF + wr * 64 + m * 16 + fr) * ldc + col0;
#pragma unroll
                    for (int bj = 0; bj < 2; ++bj)
#pragma unroll
                        for (int n = 0; n < 2; ++n) bb[m][bj][n] = *(const u32x2*)(baseb + off + bj * HALF + n * 16); }
            }
#pragma unroll
            for (int m = 0; m < 4; ++m) { const size_t row = (size_t)(u.pm * BM + ai * HALF + wr * 64 + m * 16 + fr); const size_t off = row * ldc + col0; float sq = 0.f;
#pragma unroll
                for (int bj = 0; bj < 2; ++bj)
#pragma unroll
                    for (int n = 0; n < 2; ++n) { f32x4 bs;
                        if (basef) bs = *(const f32x4*)(basef + off + bj * HALF + n * 16);
                        else { const u32x2 b2 = bb[m][bj][n]; bs = (f32x4){bflo(b2.x), bfhi(b2.x), bflo(b2.y), bfhi(b2.y)}; }
                        const f32x4 v = bs + acc[ai][bj][m][n];
                        if (out) *(f32x4*)(out + off + bj * HALF + n * 16) = v;
                        if (hb) { sq += (v.x * v.x + v.y * v.y) + (v.z * v.z + v.w * v.w); *(u32x2*)(hb + off + bj * HALF + n * 16) = (u32x2){cvt_pk_bf16(v.x, v.y), cvt_pk_bf16(v.z, v.w)}; } }
                if (hb) { sq += __shfl_xor(sq, 16); sq += __shfl_xor(sq, 32); if (fq == 0) ssq[((size_t)u.pn * T + row) * 4 + wc] = sq; } }
            asm volatile("" ::: "memory");
        }
    }
};

template <class Epi, class Sched, int NSEG, int KK, int LDA, int LDB>
__device__ __forceinline__ void gemm_phase(LAS unsigned char* lds, const Gemm g, const Sched& S, const Epi& E) {
    const int tid = fresh_tid(), wid = __builtin_amdgcn_readfirstlane(tid >> 6), lane = tid & 63, wr = wid >> 2, wc = wid & 3, fr = lane & 15, fq = lane >> 4;
    constexpr int nt = KK / BK;
    unsigned voffA[2], voffB[2];
#pragma unroll
    for (int i = 0; i < 2; ++i) { int R, C; stage_rc(tid * 16 + i * 8192, R, C); const int Rb = Epi::PERM ? ((R & ~31) + perm32(R & 31)) : R;
        voffA[i] = (unsigned)(R * LDA + C) * 2u; voffB[i] = (unsigned)(Rb * LDB + C) * 2u; }
    constexpr size_t kstep = (size_t)(BK * 2);
    constexpr size_t hstepA = (size_t)HALF * LDA * 2, hstepB = (size_t)HALF * LDB * 2;
    constexpr size_t tstepA = 2 * hstepA, tstepB = 2 * hstepB;
    const unsigned ldsw = (unsigned)wid * 1024u;
    const int aoff = lds_byte(wr * 64 + fr, fq * 8), boff = lds_byte(wc * 32 + fr, fq * 8);
#define PG8_SA(b, h) (((b) * 2 + (h)) * HTB)
#define PG8_SB(b, h) ((4 + (b) * 2 + (h)) * HTB)
#define PG8_STAGE(bufoff, gbase, voff) do { _Pragma("unroll") for (int _i = 0; _i < 2; ++_i) \
        __builtin_amdgcn_global_load_lds((const unsigned*)((const char*)(gbase) + (voff)[_i]), (LAS unsigned*)(lds + (bufoff) + ldsw + _i * 8192), 16, 0, 0); } while (0)
#define PG8_LDA(dst, b, h) do { _Pragma("unroll") for (int m = 0; m < 4; ++m) _Pragma("unroll") for (int k = 0; k < 2; ++k) dst[m][k] = *(const LAS bf16x8*)(lds + PG8_SA(b, h) + aoff + m * 2048 + k * 1024); } while (0)
#define PG8_LDB(dst, b, h) do { _Pragma("unroll") for (int n = 0; n < 2; ++n) _Pragma("unroll") for (int k = 0; k < 2; ++k) dst[n][k] = *(const LAS bf16x8*)(lds + PG8_SB(b, h) + boff + n * 2048 + k * 1024); } while (0)
#define PG8_MMA(ai, bj, At, Bt) do { __builtin_amdgcn_s_setprio(1); _Pragma("unroll") for (int m = 0; m < 4; ++m) _Pragma("unroll") for (int n = 0; n < 2; ++n) _Pragma("unroll") for (int k = 0; k < 2; ++k) \
        acc[ai][bj][m][n] = __builtin_amdgcn_mfma_f32_16x16x32_bf16(Bt[n][k], At[m][k], acc[ai][bj][m][n], 0, 0, 0); __builtin_amdgcn_s_setprio(0); } while (0)
#define PG8_WAIT_V(n) asm volatile("s_waitcnt vmcnt(" #n ")" ::: "memory")
#define PG8_WAIT_L(n) asm volatile("s_waitcnt lgkmcnt(" #n ")" ::: "memory")
#define PG8_BAR __builtin_amdgcn_s_barrier()
#define PG8_SCHED __builtin_amdgcn_sched_barrier(0)
#define PG8_APTR(u) ((const char*)((NSEG == 1 || (u).seg == 0) ? g.A0 : (u).seg == 1 ? g.A1 : g.A2) + (size_t)(u).pm * tstepA)
#define PG8_BPTR(u) ((const char*)((NSEG == 1 || (u).seg == 0) ? g.B0 : (u).seg == 1 ? g.B1 : g.B2) + (size_t)(u).pn * tstepB)
    Unit cur, nxt; int ui = 0;
    if (!S.next(0, cur)) return;
    f32x4 acc[2][2][4][2];
#pragma unroll
    for (int a = 0; a < 2; ++a)
#pragma unroll
        for (int b = 0; b < 2; ++b)
#pragma unroll
            for (int m = 0; m < 4; ++m)
#pragma unroll
                for (int n = 0; n < 2; ++n) acc[a][b][m][n] = (f32x4){0.f, 0.f, 0.f, 0.f};
    bf16x8 At[4][2], B0[2][2], B1[2][2];
    const char* cA = PG8_APTR(cur); const char* cB = PG8_BPTR(cur);
    PG8_STAGE(PG8_SB(0, 0), cB, voffB); PG8_STAGE(PG8_SB(0, 1), cB + hstepB, voffB); PG8_STAGE(PG8_SA(0, 0), cA, voffA); PG8_STAGE(PG8_SA(0, 1), cA + hstepA, voffA);
    if (wr == 1) PG8_BAR;
    PG8_WAIT_V(2); PG8_BAR;
    PG8_STAGE(PG8_SB(1, 0), cB + kstep, voffB); PG8_STAGE(PG8_SA(1, 0), cA + kstep, voffA); PG8_STAGE(PG8_SB(1, 1), cB + hstepB + kstep, voffB);
    PG8_WAIT_V(6); PG8_BAR;
    for (;;) {
        const bool has_next = S.next(ui + 1, nxt);
        const char* nA = has_next ? PG8_APTR(nxt) : cA; const char* nB = has_next ? PG8_BPTR(nxt) : cB;
        for (int t = 0; t < nt; t += 2) {
            const bool last = (t == nt - 2);
            const char* a1 = cA + (size_t)(t + 1) * kstep;
            const char* a2 = last ? nA : cA + (size_t)(t + 2) * kstep; const char* b2 = last ? nB : cB + (size_t)(t + 2) * kstep;
            const char* a3 = a2 + kstep; const char* b3 = b2 + kstep;
            PG8_LDB(B0, 0, 0); PG8_LDB(B1, 0, 1); PG8_SCHED; PG8_LDA(At, 0, 0); PG8_STAGE(PG8_SA(1, 1), a1 + hstepA, voffA);
            PG8_WAIT_V(8); PG8_WAIT_L(0); PG8_BAR; PG8_MMA(0, 0, At, B0); PG8_MMA(0, 1, At, B1); PG8_BAR; PG8_SCHED;
            PG8_LDA(At, 0, 1); PG8_STAGE(PG8_SB(0, 0), b2, voffB); PG8_STAGE(PG8_SB(0, 1), b2 + hstepB, voffB); PG8_STAGE(PG8_SA(0, 0), a2, voffA);
            PG8_WAIT_V(8); PG8_WAIT_L(0); PG8_BAR; PG8_MMA(1, 0, At, B0); PG8_MMA(1, 1, At, B1); PG8_BAR; PG8_SCHED;
            PG8_LDB(B0, 1, 0); PG8_LDB(B1, 1, 1); PG8_SCHED; PG8_LDA(At, 1, 0); PG8_STAGE(PG8_SA(0, 1), a2 + hstepA, voffA);
            PG8_WAIT_V(8); PG8_WAIT_L(0); PG8_BAR; PG8_MMA(0, 0, At, B0); PG8_MMA(0, 1, At, B1); PG8_BAR; PG8_SCHED;
            PG8_LDA(At, 1, 1); PG8_STAGE(PG8_SB(1, 0), b3, voffB); PG8_STAGE(PG8_SB(1, 1), b3 + hstepB, voffB); PG8_STAGE(PG8_SA(1, 0), a3, voffA);
            PG8_WAIT_V(8); PG8_WAIT_L(0); PG8_BAR; PG8_MMA(1, 0, At, B0); PG8_MMA(1, 1, At, B1); PG8_BAR; PG8_SCHED;
        }
        if (wr == 0) PG8_BAR;
        { const int t_e = fresh_tid(); int fr_e = t_e & 15, fq_e = (t_e >> 4) & 3; int wr_e = wr, wc_e = wc; asm volatile("" : "+s"(wr_e), "+s"(wc_e));
          E(acc, cur, wr_e, wc_e, fr_e, fq_e); }
        if (!has_next) break;
        if (!E.keep(cur)) {
#pragma unroll
            for (int a = 0; a < 2; ++a)
#pragma unroll
                for (int b = 0; b < 2; ++b)
#pragma unroll
                    for (int m = 0; m < 4; ++m)
#pragma unroll
                        for (int n = 0; n < 2; ++n) acc[a][b][m][n] = (f32x4){0.f, 0.f, 0.f, 0.f};
        }
        cur = nxt; cA = nA; cB = nB; ++ui;
        if (wr == 1) PG8_BAR;
    }
    PG8_WAIT_V(0);
    PG8_BAR;
#undef PG8_SA
#undef PG8_SB
#undef PG8_STAGE
#undef PG8_LDA
#undef PG8_LDB
#undef PG8_MMA
#undef PG8_WAIT_V
#undef PG8_WAIT_L
#undef PG8_BAR
#undef PG8_SCHED
#undef PG8_APTR
#undef PG8_BPTR
}
}

template <bool UPMAP = false>
__device__ __forceinline__ void transpose_item(const float* W, int ldw, int ncols, bf16_t* WT, int K, int row_off, LAS float* scr, int item, int lane, const float* gk = nullptr) {
    const int nblk = ncols / 32, kb = item / nblk, nb = item % nblk, k0 = 64 * kb, n0 = 32 * nb;
    if (UPMAP) { const int c2 = n0 < DFF ? n0 : n0 - DFF; row_off = 256 * (c2 >> 7) + (n0 < DFF ? 0 : 128) + (c2 & 127) - n0; }
#pragma unroll
    for (int i = 0; i < 32; ++i) { const int kk = 2 * i + (lane >> 5); float wv = W[(size_t)(k0 + kk) * ldw + n0 + (lane & 31)]; if (gk) wv *= gk[k0 + kk]; scr[kk * 33 + (lane & 31)] = wv; }
    LDS_WAIT(); asm volatile("" ::: "memory");
    const int c = lane & 7;
#pragma unroll
    for (int j = 0; j < 4; ++j) { const int n = (lane >> 3) + 8 * j; const LAS float* s = scr + (8 * c) * 33 + n;
        u32x4 o; o.x = pk2(s[0 * 33], s[1 * 33]); o.y = pk2(s[2 * 33], s[3 * 33]); o.z = pk2(s[4 * 33], s[5 * 33]); o.w = pk2(s[6 * 33], s[7 * 33]);
        *(u32x4*)(WT + (size_t)(row_off + n0 + n) * K + k0 + 8 * c) = o; }
    LDS_WAIT(); asm volatile("" ::: "memory");
}
__device__ __forceinline__ void rms_row_to_bf16(const float* xrow, const float* g, bf16_t* orow, int lane) {
    const f32x4* xr = (const f32x4*)xrow + lane; const f32x4* gr = (const f32x4*)g + lane;
    f32x4 v[4]; float s = 0.f;
#pragma unroll
    for (int j = 0; j < 4; ++j) { v[j] = xr[64 * j]; s += (v[j].x * v[j].x + v[j].y * v[j].y) + (v[j].z * v[j].z + v[j].w * v[j].w); }
    const float rstd = 1.0f / sqrtf(wave_sum(s) * (1.f / DM) + EPS);
    unsigned long long* o8 = (unsigned long long*)orow + lane;
#pragma unroll
    for (int j = 0; j < 4; ++j) { const f32x4 gg = gr[64 * j];
        o8[64 * j] = (unsigned long long)pk2(v[j].x * rstd * gg.x, v[j].y * rstd * gg.y) | ((unsigned long long)pk2(v[j].z * rstd * gg.z, v[j].w * rstd * gg.w) << 32); }
}
__device__ __forceinline__ void rms_2rows_to_bf16(const float* x0, const float* x1, const float* g, bf16_t* o0, bf16_t* o1, int lane) {
    const f32x4* xa = (const f32x4*)x0 + lane; const f32x4* xb = (const f32x4*)x1 + lane; const f32x4* gr = (const f32x4*)g + lane;
    f32x4 va[4], vb[4]; float sa = 0.f, sb = 0.f;
#pragma unroll
    for (int j = 0; j < 4; ++j) { va[j] = xa[64 * j]; vb[j] = xb[64 * j]; }
#pragma unroll
    for (int j = 0; j < 4; ++j) { sa += (va[j].x * va[j].x + va[j].y * va[j].y) + (va[j].z * va[j].z + va[j].w * va[j].w); sb += (vb[j].x * vb[j].x + vb[j].y * vb[j].y) + (vb[j].z * vb[j].z + vb[j].w * vb[j].w); }
    const float ra = 1.0f / sqrtf(wave_sum(sa) * (1.f / DM) + EPS), rb = 1.0f / sqrtf(wave_sum(sb) * (1.f / DM) + EPS);
    unsigned long long* pa = (unsigned long long*)o0 + lane; unsigned long long* pb = (unsigned long long*)o1 + lane;
#pragma unroll
    for (int j = 0; j < 4; ++j) { const f32x4 gg = gr[64 * j];
        pa[64 * j] = (unsigned long long)pk2(va[j].x * ra * gg.x, va[j].y * ra * gg.y) | ((unsigned long long)pk2(va[j].z * ra * gg.z, va[j].w * ra * gg.w) << 32);
        pb[64 * j] = (unsigned long long)pk2(vb[j].x * rb * gg.x, vb[j].y * rb * gg.y) | ((unsigned long long)pk2(vb[j].z * rb * gg.z, vb[j].w * rb * gg.w) << 32); }
}
__device__ __forceinline__ void rms_row_f32_inplace(float* xrow, const float* g, int lane) {
    f32x4* xr = (f32x4*)xrow + lane; const f32x4* gr = (const f32x4*)g + lane;
    f32x4 v[4]; float s = 0.f;
#pragma unroll
    for (int j = 0; j < 4; ++j) { v[j] = xr[64 * j]; s += (v[j].x * v[j].x + v[j].y * v[j].y) + (v[j].z * v[j].z + v[j].w * v[j].w); }
    const float rstd = 1.0f / sqrtf(wave_sum(s) * (1.f / DM) + EPS);
#pragma unroll
    for (int j = 0; j < 4; ++j) { const f32x4 gg = gr[64 * j]; xr[64 * j] = v[j] * rstd * gg; }
}

__device__ __forceinline__ f32x4 mfma16(bf16x8 a, bf16x8 b, f32x4 c) { return __builtin_amdgcn_mfma_f32_16x16x32_bf16(a, b, c, 0, 0, 0); }

template <bool FULL>
__device__ __forceinline__ void gla_segment(LAS unsigned char* L, bf16_t* Z, const float* w_alpha, const float* b_alpha, const float* norm_g, int unit, float* Sbuf, float* Btot) {
    const int tid = fresh_tid(), lane = tid & 63, w = tid >> 6, quad = lane >> 4, l15 = lane & 15;
    const int kcol = tid & 127, qtr = tid >> 7;
    const int b = unit >> 5, h = (unit >> 3) & 3, seg = unit & 7;
    LAS bf16_t* QI = (LAS bf16_t*)(L + 0);
    LAS bf16_t* KI = (LAS bf16_t*)(L + 17408);
    LAS float*  OL = (LAS float*)(L + 0);
    LAS bf16_t* QT = (LAS bf16_t*)(L + 34816);
    LAS bf16_t* KTt = (LAS bf16_t*)(L + 52224);
    LAS bf16_t* Vt = (LAS bf16_t*)(L + 70656);
    LAS bf16_t* Pm = (LAS bf16_t*)(L + 89088);
    LAS bf16_t* St = (LAS bf16_t*)(L + 98304);
    LAS float*  GAs = (LAS float*)(L + 133120);
    LAS float*  PART = (LAS float*)(L + 137216);
    LAS float*  Dd = (LAS float*)(L + 139264);

    float wa[16];
#pragma unroll
    for (int r = 0; r < 16; ++r) wa[r] = w_alpha[r * 512 + h * 128 + kcol] * 1.4426950408889634f;
    const float ba = b_alpha[h * 128 + kcol] * 1.4426950408889634f;
    f32x4 S[8];
#pragma unroll
    for (int t = 0; t < 8; ++t) S[t] = (f32x4){0.f, 0.f, 0.f, 0.f};
    float btot = 0.f;
    if (FULL) {
        if (seg > 0) {
            float cv[32], cb4[4], nv[32], nb4[4];
            { const int up = unit - seg; const float* sb = Sbuf + (size_t)up * 16384 + tid;
#pragma unroll
              for (int j = 0; j < 4; ++j) cb4[j] = Btot[up * 128 + w * 16 + quad * 4 + j];
#pragma unroll
              for (int q = 0; q < 32; ++q) cv[q] = sb[q * 512]; }
            for (int sp = 0; sp < seg; ++sp) {
                const bool hn = sp + 1 < seg; const int upn = unit - seg + (hn ? sp + 1 : sp); const float* sbn = Sbuf + (size_t)upn * 16384 + tid;
#pragma unroll
                for (int j = 0; j < 4; ++j) nb4[j] = Btot[upn * 128 + w * 16 + quad * 4 + j];
#pragma unroll
                for (int q = 0; q < 32; ++q) nv[q] = sbn[q * 512];
                float d[4];
#pragma unroll
                for (int j = 0; j < 4; ++j) d[j] = __builtin_amdgcn_exp2f(cb4[j]);
#pragma unroll
                for (int t = 0; t < 8; ++t)
#pragma unroll
                    for (int j = 0; j < 4; ++j) S[t][j] = S[t][j] * d[j] + cv[t * 4 + j];
#pragma unroll
                for (int j = 0; j < 4; ++j) cb4[j] = nb4[j];
#pragma unroll
                for (int q = 0; q < 32; ++q) cv[q] = nv[q];
            }
        }
#pragma unroll
        for (int t = 0; t < 8; ++t) *(LAS u32x2*)(St + (t * 16 + l15) * 136 + w * 16 + quad * 4) = (u32x2){pk2(S[t][0], S[t][1]), pk2(S[t][2], S[t][3])}    ;
    }
    __syncthreads();

    unsigned short qraw[16], kraw[16], vraw[16], garaw[2], knx[16], vnx[16], ganx[2];
#define GLA_ISSUE(nn) do { const size_t tb_ = (size_t)b * SEQ + (size_t)(seg * 8 + (nn)) * 64; const bf16_t* zq_ = Z + (tb_ + qtr * 16) * ZLD + h * 128 + kcol; \
        _Pragma("unroll") for (int r = 0; r < 16; ++r) { asm volatile("" : "+v"(zq_)); if (FULL) { qraw[r] = zq_[ZQ]; kraw[r] = zq_[ZK]; vraw[r] = zq_[ZV]; } else { knx[r] = zq_[ZK]; vnx[r] = zq_[ZV]; } zq_ += ZLD; } \
        const unsigned short g0_ = Z[(tb_ + (tid >> 4)) * ZLD + ZGA + (tid & 15)], g1_ = Z[(tb_ + 32 + (tid >> 4)) * ZLD + ZGA + (tid & 15)]; \
        if (FULL) { garaw[0] = g0_; garaw[1] = g1_; } else { ganx[0] = g0_; ganx[1] = g1_; } } while (0)
#define GLA_ROTATE() do { if (!FULL) { _Pragma("unroll") for (int r = 0; r < 16; ++r) { kraw[r] = knx[r]; vraw[r] = vnx[r]; } garaw[0] = ganx[0]; garaw[1] = ganx[1]; } } while (0)
    GLA_ISSUE(0); GLA_ROTATE();
    for (int n = 0; n < 8; ++n) {
        const size_t tb = (size_t)b * SEQ + (size_t)(seg * 8 + n) * 64;
        if (!FULL && n + 1 < 8) GLA_ISSUE(n + 1);
        GAs[tid] = bf2f(garaw[0]); GAs[tid + 512] = bf2f(garaw[1]);
        __syncthreads();
        float c[16]; float run = 0.f;
#pragma unroll
        for (int r = 0; r < 16; ++r) { const int i = qtr * 16 + r;
            const LAS f32x4* gp = (const LAS f32x4*)(GAs + i * 16);
            f32x2 a2 = (f32x2){ba, 0.f};
#pragma unroll
            for (int q4 = 0; q4 < 4; ++q4) { const f32x4 g4 = gp[q4];
                a2 = a2 + (f32x2){g4.x, g4.y} * (f32x2){wa[4 * q4], wa[4 * q4 + 1]}; a2 = a2 + (f32x2){g4.z, g4.w} * (f32x2){wa[4 * q4 + 2], wa[4 * q4 + 3]}; }
            const float x = a2.x + a2.y;
            const float ls = fminf(x, 0.f) - __builtin_amdgcn_logf(1.0f + __builtin_amdgcn_exp2f(-fabsf(x)));
            run += ls * (1.0f / 16.0f); c[r] = run; }
        PART[qtr * 128 + kcol] = run;
        __syncthreads();
        const float p0 = PART[kcol], p1 = PART[128 + kcol], p2 = PART[256 + kcol], p3 = PART[384 + kcol];
        const float off = (qtr > 0 ? p0 : 0.f) + (qtr > 1 ? p1 : 0.f) + (qtr > 2 ? p2 : 0.f);
        const float bref = p0 + p1, blast = (p0 + p1) + (p2 + p3);
        btot += blast;
        {
            const float ebr = __builtin_amdgcn_exp2f(bref), elb = __builtin_amdgcn_exp2f(blast - bref);
            unsigned ktp[8], vp[8];
#pragma unroll
            for (int r = 0; r < 16; ++r) { const int i = qtr * 16 + r; const float bi = off + c[r];
                const float e1 = __builtin_amdgcn_exp2f(bi - bref), e1r = __builtin_amdgcn_exp2f(bref - bi);
                const float k = bf2f(kraw[r]); const unsigned vb = vraw[r];
                if (FULL) { const float q = bf2f(qraw[r]) * 0.08838834764831845f;
                    QI[i * 136 + kcol] = (bf16_t)hwbf(q * e1); KI[i * 136 + kcol] = (bf16_t)hwbf(k * e1r); QT[i * 136 + kcol] = (bf16_t)hwbf(q * e1 * ebr); }
                const unsigned kt = hwbf(k * e1r * elb);
                if (r & 1) { ktp[r >> 1] |= kt << 16; vp[r >> 1] |= vb << 16; } else { ktp[r >> 1] = kt; vp[r >> 1] = vb; } }
            *(LAS u32x4*)(KTt + kcol * 72 + qtr * 16) = (u32x4){ktp[0], ktp[1], ktp[2], ktp[3]}; *(LAS u32x4*)(KTt + kcol * 72 + qtr * 16 + 8) = (u32x4){ktp[4], ktp[5], ktp[6], ktp[7]};
            *(LAS u32x4*)(Vt + kcol * 72 + qtr * 16) = (u32x4){vp[0], vp[1], vp[2], vp[3]}; *(LAS u32x4*)(Vt + kcol * 72 + qtr * 16 + 8) = (u32x4){vp[4], vp[5], vp[6], vp[7]};
            if (qtr == 0) Dd[kcol] = __builtin_amdgcn_exp2f(blast);
        }
        __syncthreads();
        if (FULL && n + 1 < 8) GLA_ISSUE(n + 1);
        const int oi = tid >> 3, vs = (tid & 7) * 16;
        bf16_t* zr = Z + (tb + oi) * ZLD + ZR + h * 128 + vs;
        u32x4 g8[2];
        if (FULL) { g8[0] = *(const u32x4*)zr; g8[1] = *(const u32x4*)(zr + 8); }
        if (FULL) {
            {
                const int mi = w >> 1;
#pragma unroll
                for (int nn = 0; nn < 2; ++nn) { const int nj = (w & 1) * 2 + nn; f32x4 a4 = (f32x4){0.f, 0.f, 0.f, 0.f};
#pragma unroll
                    for (int ks = 0; ks < 4; ++ks) a4 = mfma16(*(const LAS bf16x8*)(QI + (mi * 16 + l15) * 136 + ks * 32 + quad * 8), *(const LAS bf16x8*)(KI + (nj * 16 + l15) * 136 + ks * 32 + quad * 8), a4);
#pragma unroll
                    for (int j = 0; j < 4; ++j) { const int i = mi * 16 + quad * 4 + j, jj = nj * 16 + l15; Pm[i * 72 + jj] = (bf16_t)hwbf(jj <= i ? a4[j] : 0.f); } }
            }
            __syncthreads();
            {
                const int mi = w >> 1; f32x4 o4[4];
#pragma unroll
                for (int t = 0; t < 4; ++t) o4[t] = (f32x4){0.f, 0.f, 0.f, 0.f};
#pragma unroll
                for (int ks = 0; ks < 2; ++ks) { const bf16x8 a = *(const LAS bf16x8*)(Pm + (mi * 16 + l15) * 72 + ks * 32 + quad * 8);
#pragma unroll
                    for (int t = 0; t < 4; ++t) { const int nv = (w & 1) * 4 + t; o4[t] = mfma16(a, *(const LAS bf16x8*)(Vt + (nv * 16 + l15) * 72 + ks * 32 + quad * 8), o4[t]); } }
#pragma unroll
                for (int ks = 0; ks < 4; ++ks) { const bf16x8 a = *(const LAS bf16x8*)(QT + (mi * 16 + l15) * 136 + ks * 32 + quad * 8);
#pragma unroll
                    for (int t = 0; t < 4; ++t) { const int nv = (w & 1) * 4 + t; o4[t] = mfma16(a, *(const LAS bf16x8*)(St + (nv * 16 + l15) * 136 + ks * 32 + quad * 8), o4[t]); } }
#pragma unroll
                for (int t = 0; t < 4; ++t) { const int nv = (w & 1) * 4 + t;
#pragma unroll
                    for (int j = 0; j < 4; ++j) OL[(mi * 16 + quad * 4 + j) * 132 + nv * 16 + l15] = o4[t][j]; }
            }
            __syncthreads();
        }
        {
            float dk[4];
#pragma unroll
            for (int j = 0; j < 4; ++j) dk[j] = Dd[w * 16 + quad * 4 + j];
            bf16x8 ka[2];
#pragma unroll
            for (int ks = 0; ks < 2; ++ks) ka[ks] = *(const LAS bf16x8*)(KTt + (w * 16 + l15) * 72 + ks * 32 + quad * 8);
#pragma unroll
            for (int t = 0; t < 8; ++t) {
#pragma unroll
                for (int j = 0; j < 4; ++j) S[t][j] *= dk[j];
#pragma unroll
                for (int ks = 0; ks < 2; ++ks) S[t] = mfma16(ka[ks], *(const LAS bf16x8*)(Vt + (t * 16 + l15) * 72 + ks * 32 + quad * 8), S[t]);
                if (FULL) *(LAS u32x2*)(St + (t * 16 + l15) * 136 + w * 16 + quad * 4) = (u32x2){pk2(S[t][0], S[t][1]), pk2(S[t][2], S[t][3])}    ;
            }
        }
        if (FULL) {
            f32x4 ov[4]; float ss = 0.f;
#pragma unroll
            for (int e = 0; e < 4; ++e) { ov[e] = *(const LAS f32x4*)(OL + oi * 132 + vs + 4 * e); ss += (ov[e].x * ov[e].x + ov[e].y * ov[e].y) + (ov[e].z * ov[e].z + ov[e].w * ov[e].w); }
            ss += __shfl_xor(ss, 1); ss += __shfl_xor(ss, 2); ss += __shfl_xor(ss, 4);
            const float rstd = __builtin_amdgcn_rsqf(ss * (1.0f / 128.0f) + EPS);
            const float* ng = norm_g + h * 128 + vs;
#pragma unroll
            for (int hh = 0; hh < 2; ++hh) {
                const float gr[8] = {bflo(g8[hh].x), bfhi(g8[hh].x), bflo(g8[hh].y), bfhi(g8[hh].y), bflo(g8[hh].z), bfhi(g8[hh].z), bflo(g8[hh].w), bfhi(g8[hh].w)};
                const f32x4 n0 = *(const f32x4*)(ng + 8 * hh), n1 = *(const f32x4*)(ng + 8 * hh + 4);
                const f32x4 a0 = ov[2 * hh], a1 = ov[2 * hh + 1];
                float r8[8];
#pragma unroll
                for (int e = 0; e < 4; ++e) { r8[e] = a0[e] * rstd * n0[e] * siluf_(gr[e]); r8[4 + e] = a1[e] * rstd * n1[e] * siluf_(gr[4 + e]); }
                *(u32x4*)(zr + 8 * hh) = (u32x4){cvt_pk_bf16(r8[0], r8[1]), cvt_pk_bf16(r8[2], r8[3]), cvt_pk_bf16(r8[4], r8[5]), cvt_pk_bf16(r8[6], r8[7])}; }
        }
        if (n + 1 < 8) GLA_ROTATE();
    }
    if (!FULL) {
        float* sb = Sbuf + (size_t)unit * 16384 + tid;
#pragma unroll
        for (int t = 0; t < 8; ++t)
#pragma unroll
            for (int j = 0; j < 4; ++j) sb[(t * 4 + j) * 512] = S[t][j];
        if (qtr == 0) Btot[unit * 128 + kcol] = btot;
    }
    __syncthreads();
}


__device__ __forceinline__ void swa_unit(LAS unsigned char* L, bf16_t* Z, const float* sinks, int b, int qb, int kvh) {
    const int tid = fresh_tid(), lane = tid & 63, w = tid >> 6, quad = lane >> 4, l15 = lane & 15;
    LAS bf16_t* Ks = (LAS bf16_t*)(L + 0);
    LAS bf16_t* Vt = (LAS bf16_t*)(L + 36864);
    LAS bf16_t* Pw = (LAS bf16_t*)(L + 72704 + w * 5376);
    const int t0 = qb * 128; const size_t rowbase = (size_t)b * SEQ;
    const int g = w >> 1, hq = kvh * 4 + g, half = w & 1;
    bf16x8 qf[4][2];
#pragma unroll
    for (int rt = 0; rt < 4; ++rt) { const bf16_t* qp = Z + (rowbase + t0 + 64 * half + 16 * rt + l15) * ZLD + ZSQ + hq * 64 + quad * 8; qf[rt][0] = *(const bf16x8*)qp; qf[rt][1] = *(const bf16x8*)(qp + 32); }
    for (int idx = tid; idx < 2048; idx += NTHREADS) { const int row = idx >> 3, c8 = idx & 7; const int tk = t0 - 128 + row;
        u32x4 v = (u32x4){0u, 0u, 0u, 0u}; if (tk >= 0) v = *(const u32x4*)(Z + (rowbase + tk) * ZLD + ZSK + kvh * 64 + c8 * 8);
        *(LAS u32x4*)(Ks + row * 72 + c8 * 8) = v; }
#pragma unroll
    for (int g = 0; g < 4; ++g) { const int kg = w * 4 + g; unsigned pk[4];
#pragma unroll
        for (int jj = 0; jj < 8; ++jj) { const int tk = t0 - 128 + kg * 8 + jj; unsigned vb = 0u; if (tk >= 0) vb = Z[(rowbase + tk) * ZLD + ZSV + kvh * 64 + lane];
            if (jj & 1) pk[jj >> 1] |= vb << 16; else pk[jj >> 1] = vb; }
        *(LAS u32x4*)(Vt + lane * 280 + kg * 8) = (u32x4){pk[0], pk[1], pk[2], pk[3]}; }
    { unsigned zr; asm volatile("v_mov_b32 %0, 0" : "=v"(zr)); const u32x4 zv = (u32x4){zr, zr, zr, zr};
      if (tid < 128) *(LAS u32x4*)(Vt + (tid >> 1) * 280 + 256 + (tid & 1) * 8) = zv;
      if (lane < 32) *(LAS u32x4*)(Pw + (lane >> 1) * 168 + 144 + (lane & 1) * 8) = zv; }
    __syncthreads();
    const float slope = exp2f(-(float)(hq + 1)) * 1.4426950408889634f; const float sink = sinks[hq] * 1.4426950408889634f;
#pragma unroll
    for (int rt = 0; rt < 4; ++rt) {
        const int kbase = 64 * half + 16 * rt;
        const bf16x8 qa0 = qf[rt][0], qa1 = qf[rt][1];
        f32x4 sc[9];
#pragma unroll
        for (int n = 0; n < 9; ++n) { const LAS bf16_t* kb = Ks + (kbase + 16 * n + l15) * 72 + quad * 8; f32x4 a4 = (f32x4){0.f, 0.f, 0.f, 0.f};
            a4 = mfma16(qa0, *(const LAS bf16x8*)kb, a4); a4 = mfma16(qa1, *(const LAS bf16x8*)(kb + 32), a4); sc[n] = a4; }
        float mx[4] = {sink, sink, sink, sink};
#pragma unroll
        for (int n = 0; n < 9; ++n)
#pragma unroll
            for (int j = 0; j < 4; ++j) { const int qi = kbase + quad * 4 + j, kk = kbase + 16 * n + l15; const int dist = qi + 128 - kk;
                const bool valid = (dist >= 0) && (dist < 128) && (t0 - 128 + kk >= 0);
                const float lg = valid ? sc[n][j] * (0.125f * 1.4426950408889634f) - slope * (float)dist : -INFINITY; sc[n][j] = lg; mx[j] = fmaxf(mx[j], lg); }
#pragma unroll
        for (int j = 0; j < 4; ++j) { mx[j] = fmaxf(mx[j], __shfl_xor(mx[j], 1)); mx[j] = fmaxf(mx[j], __shfl_xor(mx[j], 2)); mx[j] = fmaxf(mx[j], __shfl_xor(mx[j], 4)); mx[j] = fmaxf(mx[j], __shfl_xor(mx[j], 8)); }
        float sum[4] = {0.f, 0.f, 0.f, 0.f};
#pragma unroll
        for (int n = 0; n < 9; ++n)
#pragma unroll
            for (int j = 0; j < 4; ++j) { const float p = __builtin_amdgcn_exp2f(sc[n][j] - mx[j]); sum[j] += p; Pw[(quad * 4 + j) * 168 + 16 * n + l15] = (bf16_t)hwbf(p); }
        float rden[4];
#pragma unroll
        for (int j = 0; j < 4; ++j) { sum[j] += __shfl_xor(sum[j], 1); sum[j] += __shfl_xor(sum[j], 2); sum[j] += __shfl_xor(sum[j], 4); sum[j] += __shfl_xor(sum[j], 8);
            rden[j] = __builtin_amdgcn_rcpf(sum[j] + __builtin_amdgcn_exp2f(sink - mx[j])); }
        asm volatile("s_waitcnt lgkmcnt(0)" ::: "memory");
        f32x4 o4[4];
#pragma unroll
        for (int nd = 0; nd < 4; ++nd) o4[nd] = (f32x4){0.f, 0.f, 0.f, 0.f};
#pragma unroll
        for (int ks = 0; ks < 5; ++ks) { const bf16x8 a = *(const LAS bf16x8*)(Pw + l15 * 168 + ks * 32 + quad * 8);
#pragma unroll
            for (int nd = 0; nd < 4; ++nd) o4[nd] = mfma16(a, *(const LAS bf16x8*)(Vt + (nd * 16 + l15) * 280 + kbase + ks * 32 + quad * 8), o4[nd]); }
#pragma unroll
        for (int nd = 0; nd < 4; ++nd)
#pragma unroll
            for (int j = 0; j < 4; ++j) Z[(rowbase + t0 + kbase + quad * 4 + j) * ZLD + ZSQ + hq * 64 + nd * 16 + l15] = (bf16_t)hwbf(o4[nd][j] * rden[j]);
        asm volatile("s_waitcnt lgkmcnt(0)" ::: "memory");
    }
    __syncthreads();
}


#define XB_TMO      128
#define XB_XCNT(j)  (256  + 64 * (j))
#define XB_XSUB(j)  (1280 + 64 * (j))
#define XB_XGEN(j)  (2304 + 64 * (j))
#define XB_TOP      3328
#define XB_TOPGEN   3392
#define XCD_BAR_WORDS 3456
#define XB_SPIN_CAP (1u << 18)
__device__ __forceinline__ unsigned xb_ld(unsigned* p)              { return __hip_atomic_load(p, __ATOMIC_RELAXED, __HIP_MEMORY_SCOPE_AGENT); }
__device__ __forceinline__ unsigned xb_add(unsigned* p, unsigned v) { return __hip_atomic_fetch_add(p, v, __ATOMIC_RELAXED, __HIP_MEMORY_SCOPE_AGENT); }
__device__ __forceinline__ unsigned xb_xcc_id() { return (unsigned)__builtin_amdgcn_s_getreg((3 << 11) | 20) & 0xFu; }
#define XB_SPIN(cond, bar) do { unsigned _sp = 0; while (cond) { __builtin_amdgcn_s_sleep(1); \
    if ((++_sp & 255u) == 0u) { if (xb_ld(&(bar)[XB_TMO])) break; if (_sp > XB_SPIN_CAP) { atomicAdd(&(bar)[XB_TMO], 1u); break; } } } } while (0)
struct XcdBarrier { unsigned* bar; unsigned x; volatile LAS unsigned* st; };
__device__ __forceinline__ XcdBarrier xcd_barrier_post(unsigned* bar, volatile LAS unsigned* st) {
    XcdBarrier b; b.bar = bar; b.x = xb_xcc_id(); b.st = st;
    if (threadIdx.x == 0) (void)xb_add(&bar[XB_XCNT(b.x)], 1u);
    return b;
}
__device__ __forceinline__ void xcd_barrier_complete(unsigned* bar, unsigned x, unsigned& nloc, unsigned& nx) {
    const unsigned G = gridDim.x * gridDim.y * gridDim.z;
    unsigned sum, cnt, mine, sp = 0u;
    for (;;) {
        sum = 0u; cnt = 0u; mine = 0u;
#pragma unroll
        for (unsigned j = 0; j < 16; ++j) { const unsigned c = xb_ld(&bar[XB_XCNT(j)]); sum += c; cnt += (c > 0u) ? 1u : 0u; mine = (j == x) ? c : mine; }
        if (sum == G) break;
        __builtin_amdgcn_s_sleep(1);
        if ((++sp & 255u) == 0u) { if (xb_ld(&bar[XB_TMO])) break; if (sp > XB_SPIN_CAP) { atomicAdd(&bar[XB_TMO], 1u); break; } }
    }
    nloc = mine > 0u ? mine : 1u; nx = cnt > 0u ? cnt : 1u;
}
__device__ __forceinline__ void xcd_barrier(const XcdBarrier& b) {
    asm volatile("s_waitcnt vmcnt(0)" ::: "memory");
    __syncthreads();
    if (threadIdx.x == 0) {
        unsigned* bar = b.bar; asm volatile("" : "+s"(bar));
        __builtin_amdgcn_s_waitcnt(0);
        unsigned nloc = b.st[0], nx = b.st[1];
        if (nloc == 0u) { xcd_barrier_complete(bar, b.x, nloc, nx); b.st[0] = nloc; b.st[1] = nx; }
        const unsigned old = xb_add(&bar[XB_XSUB(b.x)], 1u);
        const unsigned gen = old / nloc;
        if (old + 1u == (gen + 1u) * nloc) {
            __builtin_amdgcn_fence(__ATOMIC_RELEASE, "agent");
            asm volatile("s_waitcnt vmcnt(0)" ::: "memory");
            const unsigned og = xb_add(&bar[XB_TOP], 1u);
            const unsigned tg = og / nx;
            if (og + 1u == (tg + 1u) * nx) xb_add(&bar[XB_TOPGEN], 1u);
            else XB_SPIN(xb_ld(&bar[XB_TOPGEN]) == tg, bar);
            __builtin_amdgcn_fence(__ATOMIC_ACQUIRE, "agent");
            xb_add(&bar[XB_XGEN(b.x)], 1u);
            asm volatile("s_waitcnt vmcnt(0)" ::: "memory");
        } else {
            XB_SPIN(xb_ld(&bar[XB_XGEN(b.x)]) == gen, bar);
            __builtin_amdgcn_fence(__ATOMIC_ACQUIRE, "agent");
            asm volatile("s_waitcnt vmcnt(0)" ::: "memory");
        }
    }
    __syncthreads();
}

struct Args { const float* in[17]; float* out; unsigned char* ws; };

__global__ void __launch_bounds__(NTHREADS, 2) mega_fwd(Args args) {
    extern __shared__ __attribute__((aligned(16))) unsigned char lds_raw[];
    LAS unsigned char* lds = (LAS unsigned char*)lds_raw;
    cg::grid_group grid = cg::this_grid();
    const int G = gridDim.x, blk = blockIdx.x, NGW = G * 8;
#define FRESH_IDS() const int tid = fresh_tid(), lane = tid & 63, wave = __builtin_amdgcn_readfirstlane(tid >> 6), gw = blk * 8 + wave; (void)lane; (void)gw
    const float* x = args.in[0]; float* out = args.out;
    bf16_t* Wb = (bf16_t*)(args.ws + WS_W);
    bf16_t* U = (bf16_t*)(args.ws + WS_U);
    bf16_t* Z = (bf16_t*)(args.ws + WS_BIG);
    bf16_t* MRG = (bf16_t*)(args.ws + WS_BIG + 288 * MiB);
    float* SSQ = (float*)(args.ws + WS_SSQ);
    bf16_t* ACT = (bf16_t*)(args.ws + WS_BIG);
    float* PRE = (float*)(args.ws + WS_BIG + 176 * MiB);

    volatile LAS unsigned* MISC = (volatile LAS unsigned*)(lds + LDS_BYTES - 64);
    unsigned* barw = (unsigned*)(args.ws + WS_BAR);
    { FRESH_IDS(); if (tid < 16) MISC[tid] = 0u;
    }
    __syncthreads();
    const XcdBarrier xbar = xcd_barrier_post(barw, MISC + 8);
#define GRID_BAR() xcd_barrier(xbar)
    {
        FRESH_IDS();
        LAS float* scr = (LAS float*)(lds + wave * 16384);
        constexpr int I_A = 16 * 64, I_B = 16 * 72, I_G = 16 * 96, I_P = 8 * 32, I_O = 16 * 32, I_UP = 16 * 176, I_DN = 44 * 32;
        constexpr int I_LAYER = I_A + I_B + I_G + 3 * I_P + I_O + I_UP + I_DN;
        for (int it = gw; it < 2 * I_LAYER; it += NGW) {
            const int l = it / I_LAYER; int r = it - l * I_LAYER;
            bf16_t* WL = Wb + (size_t)l * LAYER_W;
            const float* w_in = args.in[2] + (size_t)l * DM * DIN;
            if (r < I_A) { transpose_item(w_in, DIN, 2048, WL + OW_IN, DM, 0, scr, r, lane, args.in[1] + l * DM); continue; } r -= I_A;
            if (r < I_B) { transpose_item(w_in + 2064, DIN, 2304, WL + OW_IN, DM, 2048, scr, r, lane, args.in[1] + l * DM); continue; } r -= I_B;
            if (r < I_G) { transpose_item(w_in + 4368, DIN, 3072, WL + OW_G, DM, 0, scr, r, lane, args.in[1] + l * DM); continue; } r -= I_G;
            if (r < I_P) { transpose_item(args.in[8] + (size_t)l * 512 * DM, DM, DM, WL + OW_GLA, 512, 0, scr, r, lane); continue; } r -= I_P;
            if (r < I_P) { transpose_item(args.in[9] + (size_t)l * 512 * DM, DM, DM, WL + OW_CONV, 512, 0, scr, r, lane); continue; } r -= I_P;
            if (r < I_P) { transpose_item(args.in[10] + (size_t)l * 512 * DM, DM, DM, WL + OW_SWA, 512, 0, scr, r, lane); continue; } r -= I_P;
            if (r < I_O) { transpose_item(args.in[11] + (size_t)l * DM * DM, DM, DM, WL + OW_O, DM, 0, scr, r, lane); continue; } r -= I_O;
            if (r < I_UP) { transpose_item<true>(args.in[13] + (size_t)l * DM * DFF2, DFF2, DFF2, WL + OW_UP, DM, 0, scr, r, lane, args.in[12] + l * DM); continue; } r -= I_UP;
            transpose_item(args.in[15] + (size_t)l * DFF * DM, DM, DM, WL + OW_DN, DFF, 0, scr, r, lane);
        }
        for (int idx = blk * NTHREADS + tid; idx < 2 * 256 * DM; idx += G * NTHREADS) {
            const int l = idx / (256 * DM), rem = idx - l * 256 * DM, row = rem >> 10, k = rem & 1023;
            const float v = row < 16 ? args.in[2][(size_t)l * DM * DIN + (size_t)k * DIN + 2048 + row] * args.in[1][l * DM + k] : 0.f;
            Wb[(size_t)l * LAYER_W + OW_IN + (size_t)(4352 + row) * DM + k] = (bf16_t)f2bf(v);
        }
        for (int m = gw; m < T; m += 4 * NGW) {
            f32x4 v[4][4]; float sq[4];
#pragma unroll
            for (int h4 = 0; h4 < 4; ++h4) { const int mm = m + h4 * NGW; const f32x4* xr = (const f32x4*)(x + (size_t)(mm < T ? mm : m) * DM) + lane;
#pragma unroll
                for (int j = 0; j < 4; ++j) v[h4][j] = xr[64 * j]; }
#pragma unroll
            for (int h4 = 0; h4 < 4; ++h4) { float q = 0.f;
#pragma unroll
                for (int j = 0; j < 4; ++j) q += (v[h4][j].x * v[h4][j].x + v[h4][j].y * v[h4][j].y) + (v[h4][j].z * v[h4][j].z + v[h4][j].w * v[h4][j].w);
                sq[h4] = q; }
#pragma unroll
            for (int o = 1; o < 64; o <<= 1) {
#pragma unroll
                for (int h4 = 0; h4 < 4; ++h4) sq[h4] += __shfl_xor(sq[h4], o); }
#pragma unroll
            for (int h4 = 0; h4 < 4; ++h4) { const int mm = m + h4 * NGW; if (mm < T) {
                unsigned long long* o8 = (unsigned long long*)(U + (size_t)mm * DM) + lane;
#pragma unroll
                for (int j = 0; j < 4; ++j) o8[64 * j] = (unsigned long long)pk2(v[h4][j].x, v[h4][j].y) | ((unsigned long long)pk2(v[h4][j].z, v[h4][j].w) << 32);
                if (lane < 4) *(f32x4*)(SSQ + ((size_t)lane * T + mm) * 4) = (f32x4){lane == 0 ? sq[h4] : 0.f, 0.f, 0.f, 0.f}; } }
        }
    }
    GRID_BAR();
    if (G == 0x7fffffff) grid.sync();

    for (int l = 0; l < 2; ++l) {
        const bf16_t* WL = Wb + (size_t)l * LAYER_W;
        {
            pg8::Gemm g{U, U, U, WL + OW_IN, WL + OW_IN, WL + OW_IN};
            pg8::StaticOrder<1, ZLD> S; S.init(G, blk);
            pg8::EpiBf16<0> E{Z, ZLD, SSQ};
            if (PHM & 16) pg8::gemm_phase<pg8::EpiBf16<0>, pg8::StaticOrder<1, ZLD>, 1, DM, DM, DM>(lds, g, S, E);
        }
        GRID_BAR();
        {
            float* Sbuf = (float*)(args.ws + WS_SBUF); float* Btot = (float*)(args.ws + WS_BTOT);
            if (PHM & 1) for (int u = blk; u < 256; u += G) gla_segment<false>(lds, Z, args.in[3] + (size_t)l * 16 * 512, args.in[4] + (size_t)l * 512, args.in[5] + (size_t)l * 512, u, Sbuf, Btot);
            for (int u = blk; u < NB * 32 * 2; u += G) { const int kvh = u & 1, qb = (u >> 1) & 31, b = u >> 6; if (PHM & 2) swa_unit(lds, Z, args.in[7] + l * 8, b, qb, kvh); }
        }
        GRID_BAR();
        {
            float* Sbuf = (float*)(args.ws + WS_SBUF); float* Btot = (float*)(args.ws + WS_BTOT);
            if (PHM & 1) for (int u = blk; u < 256; u += G) gla_segment<true>(lds, Z, args.in[3] + (size_t)l * 16 * 512, args.in[4] + (size_t)l * 512, args.in[5] + (size_t)l * 512, u, Sbuf, Btot);
            FRESH_IDS();
            const float* cw = args.in[6] + (size_t)l * 3 * 512;
            if (PHM & 4) for (int it = blk * NTHREADS + tid; it < (T / 4) * 64; it += G * NTHREADS) {
                const int tg = it >> 6, c8 = it & 63, t0 = tg * 4; const bool has_prev = (t0 & (SEQ - 1)) != 0;
                bf16_t* zp = Z + (size_t)t0 * ZLD + c8 * 8;
                const u32x4 z4 = (u32x4){0u, 0u, 0u, 0u};
                u32x4 xm2 = z4, cm2 = z4, xm1 = z4, cm1 = z4, xr[4], cr[4], br[4];
                if (has_prev) { xm2 = *(const u32x4*)(zp - 2 * ZLD + ZCX); cm2 = *(const u32x4*)(zp - 2 * ZLD + ZCC); xm1 = *(const u32x4*)(zp - ZLD + ZCX); cm1 = *(const u32x4*)(zp - ZLD + ZCC); }
#pragma unroll
                for (int q = 0; q < 4; ++q) { xr[q] = *(const u32x4*)(zp + (size_t)q * ZLD + ZCX); cr[q] = *(const u32x4*)(zp + (size_t)q * ZLD + ZCC); br[q] = *(const u32x4*)(zp + (size_t)q * ZLD + ZCB); }
                float w0[8], w1[8], w2[8], p2[8], p1[8];
#pragma unroll
                for (int e = 0; e < 8; ++e) { w0[e] = cw[c8 * 8 + e]; w1[e] = cw[512 + c8 * 8 + e]; w2[e] = cw[1024 + c8 * 8 + e]; }
#pragma unroll
                for (int e = 0; e < 4; ++e) { p2[2 * e] = bflo(xm2[e]) * bflo(cm2[e]); p2[2 * e + 1] = bfhi(xm2[e]) * bfhi(cm2[e]); p1[2 * e] = bflo(xm1[e]) * bflo(cm1[e]); p1[2 * e + 1] = bfhi(xm1[e]) * bfhi(cm1[e]); }
#pragma unroll
                for (int q = 0; q < 4; ++q) { float p0[8]; unsigned res[4];
#pragma unroll
                    for (int e = 0; e < 4; ++e) { p0[2 * e] = bflo(xr[q][e]) * bflo(cr[q][e]); p0[2 * e + 1] = bfhi(xr[q][e]) * bfhi(cr[q][e]); }
#pragma unroll
                    for (int e = 0; e < 4; ++e) {
                        const float lo = bflo(br[q][e]) * (w0[2 * e] * p2[2 * e] + w1[2 * e] * p1[2 * e] + w2[2 * e] * p0[2 * e]);
                        const float hi = bfhi(br[q][e]) * (w0[2 * e + 1] * p2[2 * e + 1] + w1[2 * e + 1] * p1[2 * e + 1] + w2[2 * e + 1] * p0[2 * e + 1]);
                        res[e] = pk2(lo, hi); }
                    *(u32x4*)(zp + (size_t)q * ZLD + ZCB) = (u32x4){res[0], res[1], res[2], res[3]};
#pragma unroll
                    for (int e = 0; e < 8; ++e) { p2[e] = p1[e]; p1[e] = p0[e]; } }
            }
        }
        GRID_BAR();
        {
            pg8::Gemm g{U, U, U, WL + OW_G, WL + OW_G, WL + OW_G};
            pg8::StaticOrder<1, 3072> S; S.init(G, blk);
            pg8::EpiBf16<1> E{Z, ZLD, SSQ};
            if (PHM & 32) pg8::gemm_phase<pg8::EpiBf16<1>, pg8::StaticOrder<1, 3072>, 1, DM, DM, DM>(lds, g, S, E);
        }
        GRID_BAR();
        {
            pg8::Gemm g{Z + ZR, Z + ZCB, Z + ZSQ, WL + OW_GLA, WL + OW_CONV, WL + OW_SWA};
            pg8::StaticOrder<3, DM> S; S.init(G, blk);
            pg8::EpiMerge E{Z, MRG, DM};
            if (PHM & 64) pg8::gemm_phase<pg8::EpiMerge, pg8::StaticOrder<3, DM>, 3, 512, ZLD, 512>(lds, g, S, E);
        }
        GRID_BAR();
        {
            pg8::Gemm g{MRG, MRG, MRG, WL + OW_O, WL + OW_O, WL + OW_O};
            pg8::StaticOrder<1, DM> S; S.init(G, blk);
            pg8::EpiResid E{(const float*)nullptr, U, (float*)nullptr, DM, U, SSQ};
            if (PHM & 128) pg8::gemm_phase<pg8::EpiResid, pg8::StaticOrder<1, DM>, 1, DM, DM, DM>(lds, g, S, E);
        }
        GRID_BAR();
        {
            pg8::Gemm g{U, U, U, WL + OW_UP, WL + OW_UP, WL + OW_UP};
            pg8::StaticOrder<1, DFF2> S; S.init(G, blk);
            pg8::EpiAct E{ACT, PRE, args.in[14] + (size_t)l * 3 * DFF2, lds + 131072, SSQ};
            if (PHM & 16) pg8::gemm_phase<pg8::EpiAct, pg8::StaticOrder<1, DFF2>, 1, DM, DM, DM>(lds, g, S, E);
        }
        GRID_BAR();
        {
            pg8::Gemm g{ACT, ACT, ACT, WL + OW_DN, WL + OW_DN, WL + OW_DN};
            pg8::StaticOrder<1, DM> S; S.init(G, blk);
            {
                FRESH_IDS();
                const float* fw = args.in[14] + (size_t)l * 3 * DFF2;
                pg8::Unit fu;
                for (int i = 0; S.next(i, fu); ++i) {
                    const int pm = fu.pm; const bool first = (pm & 15) == 0;
                    const float* P0 = PRE + (size_t)pm * 4 * DFF2; const float* Pp = PRE + (size_t)(pm - 1) * 4 * DFF2;
                    float fx0[6][2], fx1[6][2], fm2[6][2], fm1[6][2], fw0[6][2], fw1[6][2], fw2[6][2];
#pragma unroll
                    for (int k = 0; k < 6; ++k) { const int c = tid + k * NTHREADS;
#pragma unroll
                        for (int hbj = 0; hbj < 2; ++hbj) { const int cc = (c < DFF ? c : tid) + hbj * DFF;
                            fx0[k][hbj] = P0[cc]; fx1[k][hbj] = P0[DFF2 + cc]; fm2[k][hbj] = first ? 0.f : Pp[2 * DFF2 + cc]; fm1[k][hbj] = first ? 0.f : Pp[3 * DFF2 + cc];
                            fw0[k][hbj] = fw[cc]; fw1[k][hbj] = fw[DFF2 + cc]; fw2[k][hbj] = fw[2 * DFF2 + cc]; } }
#pragma unroll
                    for (int k = 0; k < 6; ++k) { const int c = tid + k * NTHREADS;
                        if (c < DFF) {
                            const float ra0 = fw0[k][0] * fm2[k][0] + fw1[k][0] * fm1[k][0] + fw2[k][0] * fx0[k][0], ra1 = fw0[k][0] * fm1[k][0] + fw1[k][0] * fx0[k][0] + fw2[k][0] * fx1[k][0];
                            const float rb0 = fw0[k][1] * fm2[k][1] + fw1[k][1] * fm1[k][1] + fw2[k][1] * fx0[k][1], rb1 = fw0[k][1] * fm1[k][1] + fw1[k][1] * fx0[k][1] + fw2[k][1] * fx1[k][1];
                            ACT[(size_t)(pm * 256) * DFF + c] = (bf16_t)f2bf(siluf_(ra0) * rb0);
                            ACT[(size_t)(pm * 256 + 1) * DFF + c] = (bf16_t)f2bf(siluf_(ra1) * rb1); } }
                }
                __threadfence();
                asm volatile("s_waitcnt vmcnt(0)" ::: "memory");
                __syncthreads();
                __builtin_amdgcn_fence(__ATOMIC_ACQUIRE, "agent");
            }
            pg8::EpiResid E{(const float*)nullptr, U, (float*)nullptr, DM, U, SSQ};
            if (PHM & 128) pg8::gemm_phase<pg8::EpiResid, pg8::StaticOrder<1, DM>, 1, DFF, DFF, DFF>(lds, g, S, E);
        }
        GRID_BAR();
    }
    { FRESH_IDS();
      const f32x4* gr = (const f32x4*)args.in[16] + lane;
      for (int m = gw; m < T; m += 4 * NGW) {
          u32x2 v[4][4]; f32x4 pq[4][4];
#pragma unroll
          for (int h4 = 0; h4 < 4; ++h4) { const int mm = (m + h4 * NGW) < T ? (m + h4 * NGW) : m; const u32x2* hr = (const u32x2*)(U + (size_t)mm * DM) + lane;
#pragma unroll
              for (int j = 0; j < 4; ++j) { v[h4][j] = hr[64 * j]; pq[h4][j] = *(const f32x4*)(SSQ + ((size_t)j * T + mm) * 4); } }
#pragma unroll
          for (int h4 = 0; h4 < 4; ++h4) { const int mm = m + h4 * NGW; if (mm < T) {
              float sq = 0.f;
#pragma unroll
              for (int j = 0; j < 4; ++j) sq += (pq[h4][j].x + pq[h4][j].y) + (pq[h4][j].z + pq[h4][j].w);
              const float rstd = __builtin_amdgcn_rsqf(sq * (1.f / DM) + EPS); f32x4* xw = (f32x4*)(out + (size_t)mm * DM) + lane;
#pragma unroll
              for (int j = 0; j < 4; ++j) { const f32x4 hv = (f32x4){bflo(v[h4][j].x), bfhi(v[h4][j].x), bflo(v[h4][j].y), bfhi(v[h4][j].y)}; xw[64 * j] = hv * rstd * gr[64 * j]; } } }
      }
    }
}

extern "C" void kernel_launch(void* const* d_in, const int* in_sizes, int n_in, void* d_out, int out_size, void* d_ws, size_t ws_size, hipStream_t stream) {
    static int grid_blocks = 0;
    if (grid_blocks == 0) {
        if (n_in != 17 || out_size != T * DM || ws_size < WS_END) { fprintf(stderr, "kernel_launch: unexpected shapes (n_in %d out %d ws %zu)\n", n_in, out_size, ws_size); grid_blocks = -1; return; }
        int dev = 0, cus = 0, per_cu = 0;
        hipGetDevice(&dev);
        hipDeviceGetAttribute(&cus, hipDeviceAttributeMultiprocessorCount, dev);
        if (hipFuncSetAttribute((const void*)mega_fwd, hipFuncAttributeMaxDynamicSharedMemorySize, LDS_BYTES) != hipSuccess) { fprintf(stderr, "kernel_launch: hipFuncSetAttribute failed\n"); grid_blocks = -1; return; }
        if (hipOccupancyMaxActiveBlocksPerMultiprocessor(&per_cu, (const void*)mega_fwd, NTHREADS, LDS_BYTES) != hipSuccess || per_cu < 1) { fprintf(stderr, "kernel_launch: occupancy query says %d\n", per_cu); per_cu = 1; }
        (void)hipGetLastError();
        grid_blocks = cus * (per_cu > 1 ? 1 : per_cu);
        fprintf(stderr, "kernel_launch: grid %d (cus %d, per_cu %d), ws %zu\n", grid_blocks, cus, per_cu, ws_size);
    }
    if (grid_blocks < 0) return;
    Args a{};
    for (int i = 0; i < 17; ++i) a.in[i] = (const float*)d_in[i];
    a.out = (float*)d_out; a.ws = (unsigned char*)d_ws;
    void* kargs[] = {&a};
    if (hipMemsetAsync((unsigned char*)d_ws + WS_BAR, 0, XCD_BAR_WORDS * 4, stream) != hipSuccess) { fprintf(stderr, "kernel_launch: memset of the barrier words failed\n"); return; }
    hipError_t e = hipLaunchCooperativeKernel((const void*)mega_fwd, dim3(grid_blocks), dim3(NTHREADS), kargs, LDS_BYTES, stream);
    if (e != hipSuccess) fprintf(stderr, "kernel_launch: cooperative launch failed: %s (grid %d)\n", hipGetErrorString(e), grid_blocks);
}
```

```cpp
#include <hip/hip_runtime.h>
#include <hip/hip_cooperative_groups.h>
#include <cstdio>
#include <cstdint>
#include <cmath>
namespace cg = cooperative_groups;

#define LAS __attribute__((address_space(3)))
typedef unsigned short bf16_t;
typedef short bf16x8 __attribute__((ext_vector_type(8)));
typedef float f32x4 __attribute__((ext_vector_type(4)));
typedef float f32x2 __attribute__((ext_vector_type(2)));
typedef unsigned u32x4 __attribute__((ext_vector_type(4)));
typedef unsigned u32x2 __attribute__((ext_vector_type(2)));

constexpr int NB = 8, SEQ = 4096, T = NB * SEQ, DM = 1024, DIN = 7440, DFF = 2816, DFF2 = 5632;
constexpr int ZLD = 4608;
constexpr int ZQ = 0, ZK = 512, ZV = 1024, ZR = 1536, ZCX = 2048, ZCB = 2560, ZCC = 3072, ZSQ = 3584, ZSK = 4096, ZSV = 4224, ZGA = 4352;
constexpr float EPS = 1e-6f;
constexpr size_t OW_IN = 0, OW_G = 4718592, OW_GLA = 7864320, OW_CONV = 8388608, OW_SWA = 8912896, OW_O = 9437184, OW_UP = 10485760, OW_DN = 16252928, LAYER_W = 19136512;
constexpr size_t MiB = 1u << 20;
constexpr size_t WS_W = 0, WS_BTOT = 76 * MiB, WS_BAR = 77 * MiB, WS_SSQ = 78 * MiB, WS_U = 80 * MiB, WS_BIG = 144 * MiB, WS_SBUF = 496 * MiB, WS_END = 512 * MiB;
static_assert(2 * LAYER_W * 2 <= WS_BTOT, "weights fit");
constexpr int LDS_BYTES = 147456;
constexpr int NTHREADS = 512;
#ifndef PHM
#define PHM 0xffff
#endif

__device__ __forceinline__ unsigned f2bf(float f) { unsigned u = __builtin_bit_cast(unsigned, f); return (u + 0x7fffu + ((u >> 16) & 1u)) >> 16; }
__device__ __forceinline__ unsigned pk2(float lo, float hi) { return f2bf(lo) | (f2bf(hi) << 16); }
__device__ __forceinline__ float bf2f(bf16_t h) { return __builtin_bit_cast(float, (unsigned)h << 16); }
__device__ __forceinline__ float bflo(unsigned w) { return __builtin_bit_cast(float, w << 16); }
__device__ __forceinline__ float bfhi(unsigned w) { return __builtin_bit_cast(float, w & 0xffff0000u); }
__device__ __forceinline__ unsigned cvt_pk_bf16(float lo, float hi) { unsigned r; asm volatile("s_nop 1\n\tv_cvt_pk_bf16_f32 %0, %1, %2" : "=v"(r) : "v"(lo), "v"(hi)); return r; }
__device__ __forceinline__ unsigned hwbf(float f) { return cvt_pk_bf16(f, 0.f) & 0xffffu; }
__device__ __forceinline__ float wave_sum(float v) {
#pragma unroll
    for (int o = 1; o < 64; o <<= 1) v += __shfl_xor(v, o);
    return v;
}
__device__ __forceinline__ float sigmoidf_(float x) { return __builtin_amdgcn_rcpf(1.0f + __expf(-x)); }
__device__ __forceinline__ float siluf_(float x) { return x * __builtin_amdgcn_rcpf(1.0f + __expf(-x)); }
#define LDS_WAIT() asm volatile("s_waitcnt lgkmcnt(0)" ::: "memory")
__device__ __forceinline__ int fresh_tid() { int t = threadIdx.x; asm volatile("" : "+v"(t)); return t; }

namespace pg8 {
constexpr int BM = 256, BK = 64, HALF = 128, HTB = HALF * BK * 2, STAGE_BYTES = 8 * HTB, NXCD = 8, WGM = 8;
__host__ __device__ __forceinline__ int lds_byte(int r, int c) { const int st = (r >> 4) * 2 + (c >> 5), rr = r & 15, cc = c & 31, ob = rr * 64 + cc * 2; return st * 1024 + (ob ^ (((ob >> 9) & 1) << 5)); }
__host__ __device__ __forceinline__ void stage_rc(int b, int& R, int& C) { const int st = b / 1024, sb = b % 1024, swz = sb ^ (((sb >> 9) & 1) << 5); R = (st >> 1) * 16 + swz / 64; C = (st & 1) * 32 + (swz % 64) / 2; }
__host__ __device__ __forceinline__ int perm32(int rho) { const int n = rho >> 4, i = rho & 15; return 8 * (i >> 2) + 4 * n + (i & 3); }

struct Unit { int pm, pn, seg; };
struct Gemm { const bf16_t* A0; const bf16_t* A1; const bf16_t* A2; const bf16_t* B0; const bf16_t* B1; const bf16_t* B2; };

template <int NSEG, int N_> struct StaticOrder {
    static constexpr int nM = T / BM, nN = N_ / BM, nwg = nM * nN;
    int G, c;
    __device__ __forceinline__ void init(int G_, int c_) { G = G_; c = c_; }
    __device__ __forceinline__ bool next(int i, Unit& u) const {
        const int ti = (NSEG == 1) ? i : i / NSEG; u.seg = (NSEG == 1) ? 0 : i - ti * NSEG;
        const long L = (long)ti * G + c; if (L >= nwg) return false;
        int wgid = (int)L; { const int q = nwg / NXCD, r = nwg % NXCD, xcd = wgid % NXCD, off = wgid / NXCD; wgid = (xcd < r ? xcd * (q + 1) : r * (q + 1) + (xcd - r) * q) + off; }
        const int nig = WGM * nN, gid = wgid / nig, fm = gid * WGM, gsz = (nM - fm) < WGM ? (nM - fm) : WGM;
        u.pm = fm + ((wgid % nig) % gsz); u.pn = (wgid % nig) / gsz; return true;
    }
};


__device__ __forceinline__ void scale_rows(f32x4 (&acc)[2][2][4][2], const float* ssq, const Unit& u, int wr, int fr, int fq, float mul = 1.0f) {
    f32x4 p[2][4];
#pragma unroll
    for (int ai = 0; ai < 2; ++ai)
#pragma unroll
        for (int m = 0; m < 4; ++m) { const size_t r = (size_t)(u.pm * BM + ai * HALF + wr * 64 + m * 16 + fr); p[ai][m] = *(const f32x4*)(ssq + ((size_t)fq * T + r) * 4); }
#pragma unroll
    for (int ai = 0; ai < 2; ++ai)
#pragma unroll
        for (int m = 0; m < 4; ++m) { float sq = (p[ai][m].x + p[ai][m].y) + (p[ai][m].z + p[ai][m].w);
            sq += __shfl_xor(sq, 16); sq += __shfl_xor(sq, 32);
            const float rs = __builtin_amdgcn_rsqf(sq * (1.0f / DM) + EPS) * mul;
#pragma unroll
            for (int bj = 0; bj < 2; ++bj)
#pragma unroll
                for (int n = 0; n < 2; ++n) acc[ai][bj][m][n] = acc[ai][bj][m][n] * rs; }
}

template <int MODE  > struct EpiBf16 {
    static constexpr bool PERM = true;
    bf16_t* O; int ldc; const float* ssq;
    __device__ __forceinline__ bool keep(const Unit&) const { return false; }
    __device__ __forceinline__ static int gate_zcol(int tile) {
        return tile < 4 ? tile * 256 : tile < 6 ? 1024 + (tile - 4) * 256 : tile < 8 ? ZCX + (tile - 6) * 256 : tile < 10 ? ZCC + (tile - 8) * 256 : tile == 10 ? ZSK : ZGA;
    }
    __device__ __forceinline__ void operator()(f32x4 (&acc)[2][2][4][2], const Unit& u, int wr, int wc, int fr, int fq) const {
        scale_rows(acc, ssq, u, wr, fr, fq, MODE == 1 ? -1.4426950408889634f : 1.0f);
        const int row0 = u.pm * BM + wr * 64 + fr;
        const int colt = (MODE == 1) ? gate_zcol(u.pn) : u.pn * BM;
        const int col0 = colt + wc * 32 + 8 * fq;
#pragma unroll
        for (int ai = 0; ai < 2; ++ai)
#pragma unroll
            for (int m = 0; m < 4; ++m) { bf16_t* rowp = O + (size_t)(row0 + ai * HALF + m * 16) * ldc + col0;
#pragma unroll
                for (int bj = 0; bj < 2; ++bj) { f32x4 v0 = acc[ai][bj][m][0], v1 = acc[ai][bj][m][1];
                    if (MODE == 1) {
                        unsigned g0 = 0u, g1 = 0u;
#pragma unroll
                        for (int e = 0; e < 4; ++e) { g0 = __builtin_amdgcn_cvt_pk_u8_f32(fmaxf(floorf(255.f * __builtin_amdgcn_rcpf(1.0f + __builtin_amdgcn_exp2f(v0[e])) + 0.5f), 1.f), e, g0);
                                                      g1 = __builtin_amdgcn_cvt_pk_u8_f32(fmaxf(floorf(255.f * __builtin_amdgcn_rcpf(1.0f + __builtin_amdgcn_exp2f(v1[e])) + 0.5f), 1.f), e, g1); }
                        *(u32x2*)((unsigned char*)O + ((size_t)(row0 + ai * HALF + m * 16) * ldc + colt) * 2 + bj * HALF + wc * 32 + 8 * fq) = (u32x2){g0, g1};
                    } else {
                    if (u.pn * BM + bj * HALF + wc * 32 + 8 * fq < ZGA + 16) {
                    u32x4 w; w.x = cvt_pk_bf16(v0[0], v0[1]); w.y = cvt_pk_bf16(v0[2], v0[3]); w.z = cvt_pk_bf16(v1[0], v1[1]); w.w = cvt_pk_bf16(v1[2], v1[3]);
                    *(u32x4*)(rowp + bj * HALF) = w; } } } }
    }
};

struct EpiMerge {
    static constexpr bool PERM = true;
    const bf16_t* Zg; bf16_t* O; int ldc;
    __device__ __forceinline__ bool keep(const Unit& u) const { return u.seg != 2; }
    __device__ __forceinline__ void operator()(f32x4 (&acc)[2][2][4][2], const Unit& u, int wr, int wc, int fr, int fq) const {
        const int row0 = u.pm * BM + wr * 64 + fr;
        const int seg = u.seg;
        const int gnum = EpiBf16<1>::gate_zcol(4 * seg + u.pn) * 2 + wc * 32 + 8 * fq;
        const int gden = EpiBf16<1>::gate_zcol(4 * (seg < 2 ? seg + 1 : 2) + u.pn) * 2 + wc * 32 + 8 * fq;
        const int col0 = u.pn * BM + wc * 32 + 8 * fq;
        const unsigned char* Zb = (const unsigned char*)Zg;
        u32x2 gnv[2][4][2], gdv[2][4][2];
#pragma unroll
        for (int ai = 0; ai < 2; ++ai)
#pragma unroll
            for (int m = 0; m < 4; ++m) { const size_t r = (size_t)(row0 + ai * HALF + m * 16);
#pragma unroll
                for (int bj = 0; bj < 2; ++bj) { gnv[ai][m][bj] = *(const u32x2*)(Zb + r * (ZLD * 2) + gnum + bj * HALF);
                    gdv[ai][m][bj] = (seg < 2) ? *(const u32x2*)(Zb + r * (ZLD * 2) + gden + bj * HALF) : (u32x2){0u, 0u}; } }
#pragma unroll
        for (int ai = 0; ai < 2; ++ai) {
#pragma unroll
            for (int m = 0; m < 4; ++m) { const size_t r = (size_t)(row0 + ai * HALF + m * 16);
#pragma unroll
                for (int bj = 0; bj < 2; ++bj) {
                    const u32x2 gn = gnv[ai][m][bj], gd = gdv[ai][m][bj];
                    float f[8];
#pragma unroll
                    for (int e = 0; e < 4; ++e) { f[e] = (float)((gn.x >> (8 * e)) & 0xffu); f[4 + e] = (float)((gn.y >> (8 * e)) & 0xffu); }
                    if (seg < 2) {
#pragma unroll
                        for (int e = 0; e < 4; ++e) { f[e] = f[e] * __builtin_amdgcn_rcpf((float)((gd.x >> (8 * e)) & 0xffu)); f[4 + e] = f[4 + e] * __builtin_amdgcn_rcpf((float)((gd.y >> (8 * e)) & 0xffu)); }
                    } else {
#pragma unroll
                        for (int e = 0; e < 8; ++e) f[e] = f[e] * (1.0f / 255.0f);
                    }
                    f32x4 v0 = acc[ai][bj][m][0], v1 = acc[ai][bj][m][1];
#pragma unroll
                    for (int e = 0; e < 4; ++e) { v0[e] *= f[e]; v1[e] *= f[4 + e]; }
                    acc[ai][bj][m][0] = v0; acc[ai][bj][m][1] = v1;
                    if (seg == 2) {
                        u32x4 w; w.x = cvt_pk_bf16(v0[0], v0[1]); w.y = cvt_pk_bf16(v0[2], v0[3]); w.z = cvt_pk_bf16(v1[0], v1[1]); w.w = cvt_pk_bf16(v1[2], v1[3]);
                        *(u32x4*)(O + r * ldc + col0 + bj * HALF) = w;
                    }
                } }
        }
    }
};

#define DPPF(v, ctrl) __builtin_bit_cast(float, __builtin_amdgcn_update_dpp(0, __builtin_bit_cast(int, (v)), (ctrl), 0xf, 0xf, true))
struct EpiAct {
    static constexpr bool PERM = true;
    bf16_t* ACT; float* PRE; const float* fw; LAS unsigned char* xch; const float* ssq;
    __device__ __forceinline__ bool keep(const Unit&) const { return false; }
    __device__ __forceinline__ void operator()(f32x4 (&acc)[2][2][4][2], const Unit& u, int wr, int wc, int fr, int fq) const {
        LAS float* X = (LAS float*)xch;
        const int chb = u.pn * 128 + wc * 32 + 8 * fq;
        f32x4 wq[3][2];
#pragma unroll
        for (int k = 0; k < 3; ++k)
#pragma unroll
            for (int bj = 0; bj < 2; ++bj) wq[k][bj] = *(const f32x4*)(fw + k * DFF2 + bj * DFF + chb);
        {
            LAS float* RS = X + 2048;
            const int lane_e = fq * 16 + fr;
            if (lane_e < 32) { const int rr = (wr * 4 + wc) * 32 + lane_e; const float* sp = ssq + (size_t)(u.pm * BM + rr) * 4;
                const f32x4 a0 = *(const f32x4*)sp, a1 = *(const f32x4*)(sp + (size_t)T * 4), a2 = *(const f32x4*)(sp + (size_t)T * 8), a3 = *(const f32x4*)(sp + (size_t)T * 12);
                const float sq = ((a0.x + a0.y) + (a0.z + a0.w)) + ((a1.x + a1.y) + (a1.z + a1.w)) + ((a2.x + a2.y) + (a2.z + a2.w)) + ((a3.x + a3.y) + (a3.z + a3.w));
                RS[rr] = __builtin_amdgcn_rsqf(sq * (1.0f / DM) + EPS); }
            asm volatile("s_waitcnt lgkmcnt(0)" ::: "memory"); __builtin_amdgcn_s_barrier(); asm volatile("" ::: "memory");
#pragma unroll
            for (int ai = 0; ai < 2; ++ai)
#pragma unroll
                for (int m = 0; m < 4; ++m) { const float rs = RS[ai * HALF + wr * 64 + m * 16 + fr];
#pragma unroll
                    for (int bj = 0; bj < 2; ++bj)
#pragma unroll
                        for (int n = 0; n < 2; ++n) acc[ai][bj][m][n] = acc[ai][bj][m][n] * rs; }
        }
        if (fr >= 14) {
#pragma unroll
            for (int ai = 0; ai < 2; ++ai) { LAS float* p = X + ((((ai * 2 + wr) * 4 + wc) * 2 + (fr - 14)) * 4 + fq) * 16;
#pragma unroll
                for (int bj = 0; bj < 2; ++bj)
#pragma unroll
                    for (int n = 0; n < 2; ++n) *(LAS f32x4*)(p + bj * 8 + n * 4) = acc[ai][bj][3][n]; }
            if (wr == 1) { float* q = PRE + ((size_t)u.pm * 4 + 2 + (fr - 14)) * DFF2 + chb;
#pragma unroll
                for (int bj = 0; bj < 2; ++bj)
#pragma unroll
                    for (int n = 0; n < 2; ++n) *(f32x4*)(q + bj * DFF + 4 * n) = acc[1][bj][3][n]; }
        }
        if (wr == 0 && fr < 2) { float* q = PRE + ((size_t)u.pm * 4 + fr) * DFF2 + chb;
#pragma unroll
            for (int bj = 0; bj < 2; ++bj)
#pragma unroll
                for (int n = 0; n < 2; ++n) *(f32x4*)(q + bj * DFF + 4 * n) = acc[0][bj][0][n]; }
        asm volatile("s_waitcnt lgkmcnt(0)" ::: "memory"); __builtin_amdgcn_s_barrier(); asm volatile("" ::: "memory");
#pragma unroll
        for (int n = 0; n < 2; ++n) {
            f32x4 w[3][2];
#pragma unroll
            for (int k = 0; k < 3; ++k)
#pragma unroll
                for (int bj = 0; bj < 2; ++bj) w[k][bj] = (n == 0) ? wq[k][bj] : *(const f32x4*)(fw + k * DFF2 + bj * DFF + chb + 4);
#pragma unroll
            for (int ai = 0; ai < 2; ++ai)
#pragma unroll
                for (int m = 0; m < 4; ++m) {
                    f32x4 t1[2], t2[2];
                    if (m > 0) {
#pragma unroll
                        for (int bj = 0; bj < 2; ++bj)
#pragma unroll
                            for (int e = 0; e < 4; ++e) { const float pv = acc[ai][bj][m - 1][n][e]; t1[bj][e] = DPPF(pv, 0x10F); t2[bj][e] = DPPF(pv, 0x10E); }
                    } else {
                        const bool has_pred = (wr == 1) || (ai == 1);
                        const int pai = (wr == 1) ? ai : 0, pwr = (wr == 1) ? 0 : 1;
                        const LAS float* p14 = X + ((((pai * 2 + pwr) * 4 + wc) * 2 + 0) * 4 + fq) * 16; const LAS float* p15 = p14 + 64;
#pragma unroll
                        for (int bj = 0; bj < 2; ++bj) { const f32x4 r14 = *(const LAS f32x4*)(p14 + bj * 8 + n * 4), r15 = *(const LAS f32x4*)(p15 + bj * 8 + n * 4);
#pragma unroll
                            for (int e = 0; e < 4; ++e) { t1[bj][e] = (has_pred && fr == 0) ? r15[e] : 0.f; t2[bj][e] = has_pred ? (fr == 0 ? r14[e] : (fr == 1 ? r15[e] : 0.f)) : 0.f; } }
                    }
                    float h[2][4];
#pragma unroll
                    for (int bj = 0; bj < 2; ++bj)
#pragma unroll
                        for (int e = 0; e < 4; ++e) { const float cur = acc[ai][bj][m][n][e];
                            const float p1 = DPPF(cur, 0x111) + t1[bj][e], p2 = DPPF(cur, 0x112) + t2[bj][e];
                            h[bj][e] = w[0][bj][e] * p2 + w[1][bj][e] * p1 + w[2][bj][e] * cur; }
                    float r4[4];
#pragma unroll
                    for (int c = 0; c < 4; ++c) r4[c] = siluf_(h[0][c]) * h[1][c];
                    const bool skip = (ai == 0) && (m == 0) && (wr == 0) && (fr < 2);
                    if (!skip) { u32x2 o; o.x = cvt_pk_bf16(r4[0], r4[1]); o.y = cvt_pk_bf16(r4[2], r4[3]);
                        *(u32x2*)(ACT + (size_t)(u.pm * BM + ai * HALF + wr * 64 + m * 16 + fr) * DFF + chb + 4 * n) = o; }
                }
            asm volatile("" ::: "memory");
        }
    }
};

struct EpiResid {
    static constexpr bool PERM = false;
    const float* basef; const bf16_t* baseb; float* out; int ldc; bf16_t* hb; float* ssq;
    __device__ __forceinline__ bool keep(const Unit&) const { return false; }
    __device__ __forceinline__ void operator()(f32x4 (&acc)[2][2][4][2], const Unit& u, int wr, int wc, int fr, int fq) const {
        const int col0 = u.pn * BM + wc * 32 + 4 * fq;
#pragma unroll
        for (int ai = 0; ai < 2; ++ai) {
            u32x2 bb[4][2][2];
            if (!basef) {
#pragma unroll
                for (int m = 0; m < 4; ++m) { const size_t off = (size_t)(u.pm * BM + ai * HALF + wr * 64 + m * 16 + fr) * ldc + col0;
#pragma unroll
                    for (int bj = 0; bj < 2; ++bj)
#pragma unroll
                        for (int n = 0; n < 2; ++n) bb[m][bj][n] = *(const u32x2*)(baseb + off + bj * HALF + n * 16); }
            }
#pragma unroll
            for (int m = 0; m < 4; ++m) { const size_t row = (size_t)(u.pm * BM + ai * HALF + wr * 64 + m * 16 + fr); const size_t off = row * ldc + col0; float sq = 0.f;
#pragma unroll
                for (int bj = 0; bj < 2; ++bj)
#pragma unroll
                    for (int n = 0; n < 2; ++n) { f32x4 bs;
                        if (basef) bs = *(const f32x4*)(basef + off + bj * HALF + n * 16);
                        else { const u32x2 b2 = bb[m][bj][n]; bs = (f32x4){bflo(b2.x), bfhi(b2.x), bflo(b2.y), bfhi(b2.y)}; }
                        const f32x4 v = bs + acc[ai][bj][m][n];
                        if (out) *(f32x4*)(out + off + bj * HALF + n * 16) = v;
                        if (hb) { sq += (v.x * v.x + v.y * v.y) + (v.z * v.z + v.w * v.w); *(u32x2*)(hb + off + bj * HALF + n * 16) = (u32x2){cvt_pk_bf16(v.x, v.y), cvt_pk_bf16(v.z, v.w)}; } }
                if (hb) { sq += __shfl_xor(sq, 16); sq += __shfl_xor(sq, 32); if (fq == 0) ssq[((size_t)u.pn * T + row) * 4 + wc] = sq; } }
            asm volatile("" ::: "memory");
        }
    }
};

template <class Epi, class Sched, int NSEG, int KK, int LDA, int LDB>
__device__ __forceinline__ void gemm_phase(LAS unsigned char* lds, const Gemm g, const Sched& S, const Epi& E) {
    const int tid = fresh_tid(), wid = __builtin_amdgcn_readfirstlane(tid >> 6), lane = tid & 63, wr = wid >> 2, wc = wid & 3, fr = lane & 15, fq = lane >> 4;
    constexpr int nt = KK / BK;
    unsigned voffA[2], voffB[2];
#pragma unroll
    for (int i = 0; i < 2; ++i) { int R, C; stage_rc(tid * 16 + i * 8192, R, C); const int Rb = Epi::PERM ? ((R & ~31) + perm32(R & 31)) : R;
        voffA[i] = (unsigned)(R * LDA + C) * 2u; voffB[i] = (unsigned)(Rb * LDB + C) * 2u; }
    constexpr size_t kstep = (size_t)(BK * 2);
    constexpr size_t hstepA = (size_t)HALF * LDA * 2, hstepB = (size_t)HALF * LDB * 2;
    constexpr size_t tstepA = 2 * hstepA, tstepB = 2 * hstepB;
    const unsigned ldsw = (unsigned)wid * 1024u;
    const int aoff = lds_byte(wr * 64 + fr, fq * 8), boff = lds_byte(wc * 32 + fr, fq * 8);
#define PG8_SA(b, h) (((b) * 2 + (h)) * HTB)
#define PG8_SB(b, h) ((4 + (b) * 2 + (h)) * HTB)
#define PG8_STAGE(bufoff, gbase, voff) do { _Pragma("unroll") for (int _i = 0; _i < 2; ++_i) \
        __builtin_amdgcn_global_load_lds((const unsigned*)((const char*)(gbase) + (voff)[_i]), (LAS unsigned*)(lds + (bufoff) + ldsw + _i * 8192), 16, 0, 0); } while (0)
#define PG8_LDA(dst, b, h) do { _Pragma("unroll") for (int m = 0; m < 4; ++m) _Pragma("unroll") for (int k = 0; k < 2; ++k) dst[m][k] = *(const LAS bf16x8*)(lds + PG8_SA(b, h) + aoff + m * 2048 + k * 1024); } while (0)
#define PG8_LDB(dst, b, h) do { _Pragma("unroll") for (int n = 0; n < 2; ++n) _Pragma("unroll") for (int k = 0; k < 2; ++k) dst[n][k] = *(const LAS bf16x8*)(lds + PG8_SB(b, h) + boff + n * 2048 + k * 1024); } while (0)
#define PG8_MMA(ai, bj, At, Bt) do { __builtin_amdgcn_s_setprio(1); _Pragma("unroll") for (int m = 0; m < 4; ++m) _Pragma("unroll") for (int n = 0; n < 2; ++n) _Pragma("unroll") for (int k = 0; k < 2; ++k) \
        acc[ai][bj][m][n] = __builtin_amdgcn_mfma_f32_16x16x32_bf16(Bt[n][k], At[m][k], acc[ai][bj][m][n], 0, 0, 0); __builtin_amdgcn_s_setprio(0); } while (0)
#define PG8_WAIT_V(n) asm volatile("s_waitcnt vmcnt(" #n ")" ::: "memory")
#define PG8_WAIT_L(n) asm volatile("s_waitcnt lgkmcnt(" #n ")" ::: "memory")
#define PG8_BAR __builtin_amdgcn_s_barrier()
#define PG8_SCHED __builtin_amdgcn_sched_barrier(0)
#define PG8_APTR(u) ((const char*)((NSEG == 1 || (u).seg == 0) ? g.A0 : (u).seg == 1 ? g.A1 : g.A2) + (size_t)(u).pm * tstepA)
#define PG8_BPTR(u) ((const char*)((NSEG == 1 || (u).seg == 0) ? g.B0 : (u).seg == 1 ? g.B1 : g.B2) + (size_t)(u).pn * tstepB)
    Unit cur, nxt; int ui = 0;
    if (!S.next(0, cur)) return;
    f32x4 acc[2][2][4][2];
#pragma unroll
    for (int a = 0; a < 2; ++a)
#pragma unroll
        for (int b = 0; b < 2; ++b)
#pragma unroll
            for (int m = 0; m < 4; ++m)
#pragma unroll
                for (int n = 0; n < 2; ++n) acc[a][b][m][n] = (f32x4){0.f, 0.f, 0.f, 0.f};
    bf16x8 At[4][2], B0[2][2], B1[2][2];
    const char* cA = PG8_APTR(cur); const char* cB = PG8_BPTR(cur);
    PG8_STAGE(PG8_SB(0, 0), cB, voffB); PG8_STAGE(PG8_SB(0, 1), cB + hstepB, voffB); PG8_STAGE(PG8_SA(0, 0), cA, voffA); PG8_STAGE(PG8_SA(0, 1), cA + hstepA, voffA);
    if (wr == 1) PG8_BAR;
    PG8_WAIT_V(2); PG8_BAR;
    PG8_STAGE(PG8_SB(1, 0), cB + kstep, voffB); PG8_STAGE(PG8_SA(1, 0), cA + kstep, voffA); PG8_STAGE(PG8_SB(1, 1), cB + hstepB + kstep, voffB);
    PG8_WAIT_V(6); PG8_BAR;
    for (;;) {
        const bool has_next = S.next(ui + 1, nxt);
        const char* nA = has_next ? PG8_APTR(nxt) : cA; const char* nB = has_next ? PG8_BPTR(nxt) : cB;
        for (int t = 0; t < nt; t += 2) {
            const bool last = (t == nt - 2);
            const char* a1 = cA + (size_t)(t + 1) * kstep;
            const char* a2 = last ? nA : cA + (size_t)(t + 2) * kstep; const char* b2 = last ? nB : cB + (size_t)(t + 2) * kstep;
            const char* a3 = a2 + kstep; const char* b3 = b2 + kstep;
            PG8_LDB(B0, 0, 0); PG8_LDB(B1, 0, 1); PG8_SCHED; PG8_LDA(At, 0, 0); PG8_STAGE(PG8_SA(1, 1), a1 + hstepA, voffA);
            PG8_WAIT_V(8); PG8_WAIT_L(0); PG8_BAR; PG8_MMA(0, 0, At, B0); PG8_MMA(0, 1, At, B1); PG8_BAR; PG8_SCHED;
            PG8_LDA(At, 0, 1); PG8_STAGE(PG8_SB(0, 0), b2, voffB); PG8_STAGE(PG8_SB(0, 1), b2 + hstepB, voffB); PG8_STAGE(PG8_SA(0, 0), a2, voffA);
            PG8_WAIT_V(8); PG8_WAIT_L(0); PG8_BAR; PG8_MMA(1, 0, At, B0); PG8_MMA(1, 1, At, B1); PG8_BAR; PG8_SCHED;
            PG8_LDB(B0, 1, 0); PG8_LDB(B1, 1, 1); PG8_SCHED; PG8_LDA(At, 1, 0); PG8_STAGE(PG8_SA(0, 1), a2 + hstepA, voffA);
            PG8_WAIT_V(8); PG8_WAIT_L(0); PG8_BAR; PG8_MMA(0, 0, At, B0); PG8_MMA(0, 1, At, B1); PG8_BAR; PG8_SCHED;
            PG8_LDA(At, 1, 1); PG8_STAGE(PG8_SB(1, 0), b3, voffB); PG8_STAGE(PG8_SB(1, 1), b3 + hstepB, voffB); PG8_STAGE(PG8_SA(1, 0), a3, voffA);
            PG8_WAIT_V(8); PG8_WAIT_L(0); PG8_BAR; PG8_MMA(1, 0, At, B0); PG8_MMA(1, 1, At, B1); PG8_BAR; PG8_SCHED;
        }
        if (wr == 0) PG8_BAR;
        { const int t_e = fresh_tid(); int fr_e = t_e & 15, fq_e = (t_e >> 4) & 3; int wr_e = wr, wc_e = wc; asm volatile("" : "+s"(wr_e), "+s"(wc_e));
          E(acc, cur, wr_e, wc_e, fr_e, fq_e); }
        if (!has_next) break;
        if (!E.keep(cur)) {
#pragma unroll
            for (int a = 0; a < 2; ++a)
#pragma unroll
                for (int b = 0; b < 2; ++b)
#pragma unroll
                    for (int m = 0; m < 4; ++m)
#pragma unroll
                        for (int n = 0; n < 2; ++n) acc[a][b][m][n] = (f32x4){0.f, 0.f, 0.f, 0.f};
        }
        cur = nxt; cA = nA; cB = nB; ++ui;
        if (wr == 1) PG8_BAR;
    }
    PG8_WAIT_V(0);
    PG8_BAR;
#undef PG8_SA
#undef PG8_SB
#undef PG8_STAGE
#undef PG8_LDA
#undef PG8_LDB
#undef PG8_MMA
#undef PG8_WAIT_V
#undef PG8_WAIT_L
#undef PG8_BAR
#undef PG8_SCHED
#undef PG8_APTR
#undef PG8_BPTR
}
}

template <bool UPMAP = false>
__device__ __forceinline__ void transpose_item(const float* W, int ldw, int ncols, bf16_t* WT, int K, int row_off, LAS float* scr, int item, int lane, const float* gk = nullptr) {
    const int nblk = ncols / 32, kb = item / nblk, nb = item % nblk, k0 = 64 * kb, n0 = 32 * nb;
    if (UPMAP) { const int c2 = n0 < DFF ? n0 : n0 - DFF; row_off = 256 * (c2 >> 7) + (n0 < DFF ? 0 : 128) + (c2 & 127) - n0; }
#pragma unroll
    for (int i = 0; i < 32; ++i) { const int kk = 2 * i + (lane >> 5); float wv = W[(size_t)(k0 + kk) * ldw + n0 + (lane & 31)]; if (gk) wv *= gk[k0 + kk]; scr[kk * 33 + (lane & 31)] = wv; }
    LDS_WAIT(); asm volatile("" ::: "memory");
    const int c = lane & 7;
#pragma unroll
    for (int j = 0; j < 4; ++j) { const int n = (lane >> 3) + 8 * j; const LAS float* s = scr + (8 * c) * 33 + n;
        u32x4 o; o.x = pk2(s[0 * 33], s[1 * 33]); o.y = pk2(s[2 * 33], s[3 * 33]); o.z = pk2(s[4 * 33], s[5 * 33]); o.w = pk2(s[6 * 33], s[7 * 33]);
        *(u32x4*)(WT + (size_t)(row_off + n0 + n) * K + k0 + 8 * c) = o; }
    LDS_WAIT(); asm volatile("" ::: "memory");
}
__device__ __forceinline__ void rms_row_to_bf16(const float* xrow, const float* g, bf16_t* orow, int lane) {
    const f32x4* xr = (const f32x4*)xrow + lane; const f32x4* gr = (const f32x4*)g + lane;
    f32x4 v[4]; float s = 0.f;
#pragma unroll
    for (int j = 0; j < 4; ++j) { v[j] = xr[64 * j]; s += (v[j].x * v[j].x + v[j].y * v[j].y) + (v[j].z * v[j].z + v[j].w * v[j].w); }
    const float rstd = 1.0f / sqrtf(wave_sum(s) * (1.f / DM) + EPS);
    unsigned long long* o8 = (unsigned long long*)orow + lane;
#pragma unroll
    for (int j = 0; j < 4; ++j) { const f32x4 gg = gr[64 * j];
        o8[64 * j] = (unsigned long long)pk2(v[j].x * rstd * gg.x, v[j].y * rstd * gg.y) | ((unsigned long long)pk2(v[j].z * rstd * gg.z, v[j].w * rstd * gg.w) << 32); }
}
__device__ __forceinline__ void rms_2rows_to_bf16(const float* x0, const float* x1, const float* g, bf16_t* o0, bf16_t* o1, int lane) {
    const f32x4* xa = (const f32x4*)x0 + lane; const f32x4* xb = (const f32x4*)x1 + lane; const f32x4* gr = (const f32x4*)g + lane;
    f32x4 va[4], vb[4]; float sa = 0.f, sb = 0.f;
#pragma unroll
    for (int j = 0; j < 4; ++j) { va[j] = xa[64 * j]; vb[j] = xb[64 * j]; }
#pragma unroll
    for (int j = 0; j < 4; ++j) { sa += (va[j].x * va[j].x + va[j].y * va[j].y) + (va[j].z * va[j].z + va[j].w * va[j].w); sb += (vb[j].x * vb[j].x + vb[j].y * vb[j].y) + (vb[j].z * vb[j].z + vb[j].w * vb[j].w); }
    const float ra = 1.0f / sqrtf(wave_sum(sa) * (1.f / DM) + EPS), rb = 1.0f / sqrtf(wave_sum(sb) * (1.f / DM) + EPS);
    unsigned long long* pa = (unsigned long long*)o0 + lane; unsigned long long* pb = (unsigned long long*)o1 + lane;
#pragma unroll
    for (int j = 0; j < 4; ++j) { const f32x4 gg = gr[64 * j];
        pa[64 * j] = (unsigned long long)pk2(va[j].x * ra * gg.x, va[j].y * ra * gg.y) | ((unsigned long long)pk2(va[j].z * ra * gg.z, va[j].w * ra * gg.w) << 32);
        pb[64 * j] = (unsigned long long)pk2(vb[j].x * rb * gg.x, vb[j].y * rb * gg.y) | ((unsigned long long)pk2(vb[j].z * rb * gg.z, vb[j].w * rb * gg.w) << 32); }
}
__device__ __forceinline__ void rms_row_f32_inplace(float* xrow, const float* g, int lane) {
    f32x4* xr = (f32x4*)xrow + lane; const f32x4* gr = (const f32x4*)g + lane;
    f32x4 v[4]; float s = 0.f;
#pragma unroll
    for (int j = 0; j < 4; ++j) { v[j] = xr[64 * j]; s += (v[j].x * v[j].x + v[j].y * v[j].y) + (v[j].z * v[j].z + v[j].w * v[j].w); }
    const float rstd = 1.0f / sqrtf(wave_sum(s) * (1.f / DM) + EPS);
#pragma unroll
    for (int j = 0; j < 4; ++j) { const f32x4 gg = gr[64 * j]; xr[64 * j] = v[j] * rstd * gg; }
}

__device__ __forceinline__ f32x4 mfma16(bf16x8 a, bf16x8 b, f32x4 c) { return __builtin_amdgcn_mfma_f32_16x16x32_bf16(a, b, c, 0, 0, 0); }

template <bool FULL>
__device__ __forceinline__ void gla_segment(LAS unsigned char* L, bf16_t* Z, const float* w_alpha, const float* b_alpha, const float* norm_g, int unit, float* Sbuf, float* Btot) {
    const int tid = fresh_tid(), lane = tid & 63, w = tid >> 6, quad = lane >> 4, l15 = lane & 15;
    const int kcol = tid & 127, qtr = tid >> 7;
    const int b = unit >> 5, h = (unit >> 3) & 3, seg = unit & 7;
    LAS bf16_t* QI = (LAS bf16_t*)(L + 0);
    LAS bf16_t* KI = (LAS bf16_t*)(L + 17408);
    LAS float*  OL = (LAS float*)(L + 0);
    LAS bf16_t* QT = (LAS bf16_t*)(L + 34816);
    LAS bf16_t* KTt = (LAS bf16_t*)(L + 52224);
    LAS bf16_t* Vt = (LAS bf16_t*)(L + 70656);
    LAS bf16_t* Pm = (LAS bf16_t*)(L + 89088);
    LAS bf16_t* St = (LAS bf16_t*)(L + 98304);
    LAS float*  GAs = (LAS float*)(L + 133120);
    LAS float*  PART = (LAS float*)(L + 137216);
    LAS float*  Dd = (LAS float*)(L + 139264);

    float wa[16];
#pragma unroll
    for (int r = 0; r < 16; ++r) wa[r] = w_alpha[r * 512 + h * 128 + kcol] * 1.4426950408889634f;
    const float ba = b_alpha[h * 128 + kcol] * 1.4426950408889634f;
    f32x4 S[8];
#pragma unroll
    for (int t = 0; t < 8; ++t) S[t] = (f32x4){0.f, 0.f, 0.f, 0.f};
    float btot = 0.f;
    if (FULL) {
        if (seg > 0) {
            float cv[32], cb4[4], nv[32], nb4[4];
            { const int up = unit - seg; const float* sb = Sbuf + (size_t)up * 16384 + tid;
#pragma unroll
              for (int j = 0; j < 4; ++j) cb4[j] = Btot[up * 128 + w * 16 + quad * 4 + j];
#pragma unroll
              for (int q = 0; q < 32; ++q) cv[q] = sb[q * 512]; }
            for (int sp = 0; sp < seg; ++sp) {
                const bool hn = sp + 1 < seg; const int upn = unit - seg + (hn ? sp + 1 : sp); const float* sbn = Sbuf + (size_t)upn * 16384 + tid;
#pragma unroll
                for (int j = 0; j < 4; ++j) nb4[j] = Btot[upn * 128 + w * 16 + quad * 4 + j];
#pragma unroll
                for (int q = 0; q < 32; ++q) nv[q] = sbn[q * 512];
                float d[4];
#pragma unroll
                for (int j = 0; j < 4; ++j) d[j] = __builtin_amdgcn_exp2f(cb4[j]);
#pragma unroll
                for (int t = 0; t < 8; ++t)
#pragma unroll
                    for (int j = 0; j < 4; ++j) S[t][j] = S[t][j] * d[j] + cv[t * 4 + j];
#pragma unroll
                for (int j = 0; j < 4; ++j) cb4[j] = nb4[j];
#pragma unroll
                for (int q = 0; q < 32; ++q) cv[q] = nv[q];
            }
        }
#pragma unroll
        for (int t = 0; t < 8; ++t) *(LAS u32x2*)(St + (t * 16 + l15) * 136 + w * 16 + quad * 4) = (u32x2){pk2(S[t][0], S[t][1]), pk2(S[t][2], S[t][3])}    ;
    }
    __syncthreads();

    unsigned short qraw[16], kraw[16], vraw[16], garaw[2], knx[16], vnx[16], ganx[2];
#define GLA_ISSUE(nn) do { const size_t tb_ = (size_t)b * SEQ + (size_t)(seg * 8 + (nn)) * 64; const bf16_t* zq_ = Z + (tb_ + qtr * 16) * ZLD + h * 128 + kcol; \
        _Pragma("unroll") for (int r = 0; r < 16; ++r) { asm volatile("" : "+v"(zq_)); if (FULL) { qraw[r] = zq_[ZQ]; kraw[r] = zq_[ZK]; vraw[r] = zq_[ZV]; } else { knx[r] = zq_[ZK]; vnx[r] = zq_[ZV]; } zq_ += ZLD; } \
        const unsigned short g0_ = Z[(tb_ + (tid >> 4)) * ZLD + ZGA + (tid & 15)], g1_ = Z[(tb_ + 32 + (tid >> 4)) * ZLD + ZGA + (tid & 15)]; \
        if (FULL) { garaw[0] = g0_; garaw[1] = g1_; } else { ganx[0] = g0_; ganx[1] = g1_; } } while (0)
#define GLA_ROTATE() do { if (!FULL) { _Pragma("unroll") for (int r = 0; r < 16; ++r) { kraw[r] = knx[r]; vraw[r] = vnx[r]; } garaw[0] = ganx[0]; garaw[1] = ganx[1]; } } while (0)
    GLA_ISSUE(0); GLA_ROTATE();
    for (int n = 0; n < 8; ++n) {
        const size_t tb = (size_t)b * SEQ + (size_t)(seg * 8 + n) * 64;
        if (!FULL && n + 1 < 8) GLA_ISSUE(n + 1);
        GAs[tid] = bf2f(garaw[0]); GAs[tid + 512] = bf2f(garaw[1]);
        __syncthreads();
        float c[16]; float run = 0.f;
#pragma unroll
        for (int r = 0; r < 16; ++r) { const int i = qtr * 16 + r;
            const LAS f32x4* gp = (const LAS f32x4*)(GAs + i * 16);
            f32x2 a2 = (f32x2){ba, 0.f};
#pragma unroll
            for (int q4 = 0; q4 < 4; ++q4) { const f32x4 g4 = gp[q4];
                a2 = a2 + (f32x2){g4.x, g4.y} * (f32x2){wa[4 * q4], wa[4 * q4 + 1]}; a2 = a2 + (f32x2){g4.z, g4.w} * (f32x2){wa[4 * q4 + 2], wa[4 * q4 + 3]}; }
            const float x = a2.x + a2.y;
            const float ls = fminf(x, 0.f) - __builtin_amdgcn_logf(1.0f + __builtin_amdgcn_exp2f(-fabsf(x)));
            run += ls * (1.0f / 16.0f); c[r] = run; }
        PART[qtr * 128 + kcol] = run;
        __syncthreads();
        const float p0 = PART[kcol], p1 = PART[128 + kcol], p2 = PART[256 + kcol], p3 = PART[384 + kcol];
        const float off = (qtr > 0 ? p0 : 0.f) + (qtr > 1 ? p1 : 0.f) + (qtr > 2 ? p2 : 0.f);
        const float bref = p0 + p1, blast = (p0 + p1) + (p2 + p3);
        btot += blast;
        {
            const float ebr = __builtin_amdgcn_exp2f(bref), elb = __builtin_amdgcn_exp2f(blast - bref);
            unsigned ktp[8], vp[8];
#pragma unroll
            for (int r = 0; r < 16; ++r) { const int i = qtr * 16 + r; const float bi = off + c[r];
                const float e1 = __builtin_amdgcn_exp2f(bi - bref), e1r = __builtin_amdgcn_exp2f(bref - bi);
                const float k = bf2f(kraw[r]); const unsigned vb = vraw[r];
                if (FULL) { const float q = bf2f(qraw[r]) * 0.08838834764831845f;
                    QI[i * 136 + kcol] = (bf16_t)hwbf(q * e1); KI[i * 136 + kcol] = (bf16_t)hwbf(k * e1r); QT[i * 136 + kcol] = (bf16_t)hwbf(q * e1 * ebr); }
                const unsigned kt = hwbf(k * e1r * elb);
                if (r & 1) { ktp[r >> 1] |= kt << 16; vp[r >> 1] |= vb << 16; } else { ktp[r >> 1] = kt; vp[r >> 1] = vb; } }
            *(LAS u32x4*)(KTt + kcol * 72 + qtr * 16) = (u32x4){ktp[0], ktp[1], ktp[2], ktp[3]}; *(LAS u32x4*)(KTt + kcol * 72 + qtr * 16 + 8) = (u32x4){ktp[4], ktp[5], ktp[6], ktp[7]};
            *(LAS u32x4*)(Vt + kcol * 72 + qtr * 16) = (u32x4){vp[0], vp[1], vp[2], vp[3]}; *(LAS u32x4*)(Vt + kcol * 72 + qtr * 16 + 8) = (u32x4){vp[4], vp[5], vp[6], vp[7]};
            if (qtr == 0) Dd[kcol] = __builtin_amdgcn_exp2f(blast);
        }
        __syncthreads();
        if (FULL && n + 1 < 8) GLA_ISSUE(n + 1);
        const int oi = tid >> 3, vs = (tid & 7) * 16;
        bf16_t* zr = Z + (tb + oi) * ZLD + ZR + h * 128 + vs;
        u32x4 g8[2];
        if (FULL) { g8[0] = *(const u32x4*)zr; g8[1] = *(const u32x4*)(zr + 8); }
        if (FULL) {
            {
                const int mi = w >> 1;
#pragma unroll
                for (int nn = 0; nn < 2; ++nn) { const int nj = (w & 1) * 2 + nn; f32x4 a4 = (f32x4){0.f, 0.f, 0.f, 0.f};
#pragma unroll
                    for (int ks = 0; ks < 4; ++ks) a4 = mfma16(*(const LAS bf16x8*)(QI + (mi * 16 + l15) * 136 + ks * 32 + quad * 8), *(const LAS bf16x8*)(KI + (nj * 16 + l15) * 136 + ks * 32 + quad * 8), a4);
#pragma unroll
                    for (int j = 0; j < 4; ++j) { const int i = mi * 16 + quad * 4 + j, jj = nj * 16 + l15; Pm[i * 72 + jj] = (bf16_t)hwbf(jj <= i ? a4[j] : 0.f); } }
            }
            __syncthreads();
            {
                const int mi = w >> 1; f32x4 o4[4];
#pragma unroll
                for (int t = 0; t < 4; ++t) o4[t] = (f32x4){0.f, 0.f, 0.f, 0.f};
#pragma unroll
                for (int ks = 0; ks < 2; ++ks) { const bf16x8 a = *(const LAS bf16x8*)(Pm + (mi * 16 + l15) * 72 + ks * 32 + quad * 8);
#pragma unroll
                    for (int t = 0; t < 4; ++t) { const int nv = (w & 1) * 4 + t; o4[t] = mfma16(a, *(const LAS bf16x8*)(Vt + (nv * 16 + l15) * 72 + ks * 32 + quad * 8), o4[t]); } }
#pragma unroll
                for (int ks = 0; ks < 4; ++ks) { const bf16x8 a = *(const LAS bf16x8*)(QT + (mi * 16 + l15) * 136 + ks * 32 + quad * 8);
#pragma unroll
                    for (int t = 0; t < 4; ++t) { const int nv = (w & 1) * 4 + t; o4[t] = mfma16(a, *(const LAS bf16x8*)(St + (nv * 16 + l15) * 136 + ks * 32 + quad * 8), o4[t]); } }
#pragma unroll
                for (int t = 0; t < 4; ++t) { const int nv = (w & 1) * 4 + t;
#pragma unroll
                    for (int j = 0; j < 4; ++j) OL[(mi * 16 + quad * 4 + j) * 132 + nv * 16 + l15] = o4[t][j]; }
            }
            __syncthreads();
        }
        {
            float dk[4];
#pragma unroll
            for (int j = 0; j < 4; ++j) dk[j] = Dd[w * 16 + quad * 4 + j];
            bf16x8 ka[2];
#pragma unroll
            for (int ks = 0; ks < 2; ++ks) ka[ks] = *(const LAS bf16x8*)(KTt + (w * 16 + l15) * 72 + ks * 32 + quad * 8);
#pragma unroll
            for (int t = 0; t < 8; ++t) {
#pragma unroll
                for (int j = 0; j < 4; ++j) S[t][j] *= dk[j];
#pragma unroll
                for (int ks = 0; ks < 2; ++ks) S[t] = mfma16(ka[ks], *(const LAS bf16x8*)(Vt + (t * 16 + l15) * 72 + ks * 32 + quad * 8), S[t]);
                if (FULL) *(LAS u32x2*)(St + (t * 16 + l15) * 136 + w * 16 + quad * 4) = (u32x2){pk2(S[t][0], S[t][1]), pk2(S[t][2], S[t][3])}    ;
            }
        }
        if (FULL) {
            f32x4 ov[4]; float ss = 0.f;
#pragma unroll
            for (int e = 0; e < 4; ++e) { ov[e] = *(const LAS f32x4*)(OL + oi * 132 + vs + 4 * e); ss += (ov[e].x * ov[e].x + ov[e].y * ov[e].y) + (ov[e].z * ov[e].z + ov[e].w * ov[e].w); }
            ss += __shfl_xor(ss, 1); ss += __shfl_xor(ss, 2); ss += __shfl_xor(ss, 4);
            const float rstd = __builtin_amdgcn_rsqf(ss * (1.0f / 128.0f) + EPS);
            const float* ng = norm_g + h * 128 + vs;
#pragma unroll
            for (int hh = 0; hh < 2; ++hh) {
                const float gr[8] = {bflo(g8[hh].x), bfhi(g8[hh].x), bflo(g8[hh].y), bfhi(g8[hh].y), bflo(g8[hh].z), bfhi(g8[hh].z), bflo(g8[hh].w), bfhi(g8[hh].w)};
                const f32x4 n0 = *(const f32x4*)(ng + 8 * hh), n1 = *(const f32x4*)(ng + 8 * hh + 4);
                const f32x4 a0 = ov[2 * hh], a1 = ov[2 * hh + 1];
                float r8[8];
#pragma unroll
                for (int e = 0; e < 4; ++e) { r8[e] = a0[e] * rstd * n0[e] * siluf_(gr[e]); r8[4 + e] = a1[e] * rstd * n1[e] * siluf_(gr[4 + e]); }
                *(u32x4*)(zr + 8 * hh) = (u32x4){cvt_pk_bf16(r8[0], r8[1]), cvt_pk_bf16(r8[2], r8[3]), cvt_pk_bf16(r8[4], r8[5]), cvt_pk_bf16(r8[6], r8[7])}; }
        }
        if (n + 1 < 8) GLA_ROTATE();
    }
    if (!FULL) {
        float* sb = Sbuf + (size_t)unit * 16384 + tid;
#pragma unroll
        for (int t = 0; t < 8; ++t)
#pragma unroll
            for (int j = 0; j < 4; ++j) sb[(t * 4 + j) * 512] = S[t][j];
        if (qtr == 0) Btot[unit * 128 + kcol] = btot;
    }
    __syncthreads();
}


__device__ __forceinline__ void swa_unit(LAS unsigned char* L, bf16_t* Z, const float* sinks, int b, int qb, int kvh) {
    const int tid = fresh_tid(), lane = tid & 63, w = tid >> 6, quad = lane >> 4, l15 = lane & 15;
    LAS bf16_t* Ks = (LAS bf16_t*)(L + 0);
    LAS bf16_t* Vt = (LAS bf16_t*)(L + 36864);
    LAS bf16_t* Pw = (LAS bf16_t*)(L + 72704 + w * 5376);
    const int t0 = qb * 128; const size_t rowbase = (size_t)b * SEQ;
    const int g = w >> 1, hq = kvh * 4 + g, half = w & 1;
    bf16x8 qf[4][2];
#pragma unroll
    for (int rt = 0; rt < 4; ++rt) { const bf16_t* qp = Z + (rowbase + t0 + 64 * half + 16 * rt + l15) * ZLD + ZSQ + hq * 64 + quad * 8; qf[rt][0] = *(const bf16x8*)qp; qf[rt][1] = *(const bf16x8*)(qp + 32); }
    for (int idx = tid; idx < 2048; idx += NTHREADS) { const int row = idx >> 3, c8 = idx & 7; const int tk = t0 - 128 + row;
        u32x4 v = (u32x4){0u, 0u, 0u, 0u}; if (tk >= 0) v = *(const u32x4*)(Z + (rowbase + tk) * ZLD + ZSK + kvh * 64 + c8 * 8);
        *(LAS u32x4*)(Ks + row * 72 + c8 * 8) = v; }
#pragma unroll
    for (int g = 0; g < 4; ++g) { const int kg = w * 4 + g; unsigned pk[4];
#pragma unroll
        for (int jj = 0; jj < 8; ++jj) { const int tk = t0 - 128 + kg * 8 + jj; unsigned vb = 0u; if (tk >= 0) vb = Z[(rowbase + tk) * ZLD + ZSV + kvh * 64 + lane];
            if (jj & 1) pk[jj >> 1] |= vb << 16; else pk[jj >> 1] = vb; }
        *(LAS u32x4*)(Vt + lane * 280 + kg * 8) = (u32x4){pk[0], pk[1], pk[2], pk[3]}; }
    { unsigned zr; asm volatile("v_mov_b32 %0, 0" : "=v"(zr)); const u32x4 zv = (u32x4){zr, zr, zr, zr};
      if (tid < 128) *(LAS u32x4*)(Vt + (tid >> 1) * 280 + 256 + (tid & 1) * 8) = zv;
      if (lane < 32) *(LAS u32x4*)(Pw + (lane >> 1) * 168 + 144 + (lane & 1) * 8) = zv; }
    __syncthreads();
    const float slope = exp2f(-(float)(hq + 1)) * 1.4426950408889634f; const float sink = sinks[hq] * 1.4426950408889634f;
    const int kmin = (t0 == 0) ? 128 : 0;
#pragma unroll
    for (int rt = 0; rt < 4; ++rt) {
        const int kbase = 64 * half + 16 * rt;
        const bf16x8 qa0 = qf[rt][0], qa1 = qf[rt][1];
        f32x4 sc[9];
#pragma unroll
        for (int n = 0; n < 9; ++n) { const LAS bf16_t* kb = Ks + (kbase + 16 * n + l15) * 72 + quad * 8; f32x4 a4 = (f32x4){0.f, 0.f, 0.f, 0.f};
            a4 = mfma16(qa0, *(const LAS bf16x8*)kb, a4); a4 = mfma16(qa1, *(const LAS bf16x8*)(kb + 32), a4); sc[n] = a4; }
        float mx[4] = {sink, sink, sink, sink};
#pragma unroll
        for (int n = 0; n < 9; ++n)
#pragma unroll
            for (int j = 0; j < 4; ++j) { const int qi = kbase + quad * 4 + j, kk = kbase + 16 * n + l15; const int dist = qi + 128 - kk;
                const bool valid = ((n >= 1 && n <= 7) || ((dist >= 0) && (dist < 128))) && (kk >= kmin);
                const float lg = valid ? sc[n][j] * (0.125f * 1.4426950408889634f) - slope * (float)dist : -INFINITY; sc[n][j] = lg; mx[j] = fmaxf(mx[j], lg); }
#pragma unroll
        for (int j = 0; j < 4; ++j) { mx[j] = fmaxf(mx[j], __shfl_xor(mx[j], 1)); mx[j] = fmaxf(mx[j], __shfl_xor(mx[j], 2)); mx[j] = fmaxf(mx[j], __shfl_xor(mx[j], 4)); mx[j] = fmaxf(mx[j], __shfl_xor(mx[j], 8)); }
        float sum[4] = {0.f, 0.f, 0.f, 0.f};
#pragma unroll
        for (int n = 0; n < 9; ++n)
#pragma unroll
            for (int j = 0; j < 4; ++j) { const float p = __builtin_amdgcn_exp2f(sc[n][j] - mx[j]); sum[j] += p; Pw[(quad * 4 + j) * 168 + 16 * n + l15] = (bf16_t)hwbf(p); }
        float rden[4];
#pragma unroll
        for (int j = 0; j < 4; ++j) { sum[j] += __shfl_xor(sum[j], 1); sum[j] += __shfl_xor(sum[j], 2); sum[j] += __shfl_xor(sum[j], 4); sum[j] += __shfl_xor(sum[j], 8);
            rden[j] = __builtin_amdgcn_rcpf(sum[j] + __builtin_amdgcn_exp2f(sink - mx[j])); }
        asm volatile("s_waitcnt lgkmcnt(0)" ::: "memory");
        f32x4 o4[4];
#pragma unroll
        for (int nd = 0; nd < 4; ++nd) o4[nd] = (f32x4){0.f, 0.f, 0.f, 0.f};
#pragma unroll
        for (int ks = 0; ks < 5; ++ks) { const bf16x8 a = *(const LAS bf16x8*)(Pw + l15 * 168 + ks * 32 + quad * 8);
#pragma unroll
            for (int nd = 0; nd < 4; ++nd) o4[nd] = mfma16(a, *(const LAS bf16x8*)(Vt + (nd * 16 + l15) * 280 + kbase + ks * 32 + quad * 8), o4[nd]); }
#pragma unroll
        for (int nd = 0; nd < 4; ++nd)
#pragma unroll
            for (int j = 0; j < 4; ++j) Z[(rowbase + t0 + kbase + quad * 4 + j) * ZLD + ZSQ + hq * 64 + nd * 16 + l15] = (bf16_t)hwbf(o4[nd][j] * rden[j]);
        asm volatile("s_waitcnt lgkmcnt(0)" ::: "memory");
    }
    __syncthreads();
}


#define XB_TMO      128
#define XB_XCNT(j)  (256  + 64 * (j))
#define XB_XSUB(j)  (1280 + 64 * (j))
#define XB_XGEN(j)  (2304 + 64 * (j))
#define XB_TOP      3328
#define XB_TOPGEN   3392
#define XCD_BAR_WORDS 3456
#define XB_SPIN_CAP (1u << 18)
__device__ __forceinline__ unsigned xb_ld(unsigned* p)              { return __hip_atomic_load(p, __ATOMIC_RELAXED, __HIP_MEMORY_SCOPE_AGENT); }
__device__ __forceinline__ unsigned xb_add(unsigned* p, unsigned v) { return __hip_atomic_fetch_add(p, v, __ATOMIC_RELAXED, __HIP_MEMORY_SCOPE_AGENT); }
__device__ __forceinline__ unsigned xb_xcc_id() { return (unsigned)__builtin_amdgcn_s_getreg((3 << 11) | 20) & 0xFu; }
#define XB_SPIN(cond, bar) do { unsigned _sp = 0; while (cond) { __builtin_amdgcn_s_sleep(1); \
    if ((++_sp & 255u) == 0u) { if (xb_ld(&(bar)[XB_TMO])) break; if (_sp > XB_SPIN_CAP) { atomicAdd(&(bar)[XB_TMO], 1u); break; } } } } while (0)
struct XcdBarrier { unsigned* bar; unsigned x; volatile LAS unsigned* st; };
__device__ __forceinline__ XcdBarrier xcd_barrier_post(unsigned* bar, volatile LAS unsigned* st) {
    XcdBarrier b; b.bar = bar; b.x = xb_xcc_id(); b.st = st;
    if (threadIdx.x == 0) (void)xb_add(&bar[XB_XCNT(b.x)], 1u);
    return b;
}
__device__ __forceinline__ void xcd_barrier_complete(unsigned* bar, unsigned x, unsigned& nloc, unsigned& nx) {
    const unsigned G = gridDim.x * gridDim.y * gridDim.z;
    unsigned sum, cnt, mine, sp = 0u;
    for (;;) {
        sum = 0u; cnt = 0u; mine = 0u;
#pragma unroll
        for (unsigned j = 0; j < 16; ++j) { const unsigned c = xb_ld(&bar[XB_XCNT(j)]); sum += c; cnt += (c > 0u) ? 1u : 0u; mine = (j == x) ? c : mine; }
        if (sum == G) break;
        __builtin_amdgcn_s_sleep(1);
        if ((++sp & 255u) == 0u) { if (xb_ld(&bar[XB_TMO])) break; if (sp > XB_SPIN_CAP) { atomicAdd(&bar[XB_TMO], 1u); break; } }
    }
    nloc = mine > 0u ? mine : 1u; nx = cnt > 0u ? cnt : 1u;
}
__device__ __forceinline__ void xcd_barrier(const XcdBarrier& b) {
    asm volatile("s_waitcnt vmcnt(0)" ::: "memory");
    __syncthreads();
    if (threadIdx.x == 0) {
        unsigned* bar = b.bar; asm volatile("" : "+s"(bar));
        __builtin_amdgcn_s_waitcnt(0);
        unsigned nloc = b.st[0], nx = b.st[1];
        if (nloc == 0u) { xcd_barrier_complete(bar, b.x, nloc, nx); b.st[0] = nloc; b.st[1] = nx; }
        const unsigned old = xb_add(&bar[XB_XSUB(b.x)], 1u);
        const unsigned gen = old / nloc;
        if (old + 1u == (gen + 1u) * nloc) {
            __builtin_amdgcn_fence(__ATOMIC_RELEASE, "agent");
            asm volatile("s_waitcnt vmcnt(0)" ::: "memory");
            const unsigned og = xb_add(&bar[XB_TOP], 1u);
            const unsigned tg = og / nx;
            if (og + 1u == (tg + 1u) * nx) xb_add(&bar[XB_TOPGEN], 1u);
            else XB_SPIN(xb_ld(&bar[XB_TOPGEN]) == tg, bar);
            __builtin_amdgcn_fence(__ATOMIC_ACQUIRE, "agent");
            xb_add(&bar[XB_XGEN(b.x)], 1u);
            asm volatile("s_waitcnt vmcnt(0)" ::: "memory");
        } else {
            XB_SPIN(xb_ld(&bar[XB_XGEN(b.x)]) == gen, bar);
            __builtin_amdgcn_fence(__ATOMIC_ACQUIRE, "agent");
            asm volatile("s_waitcnt vmcnt(0)" ::: "memory");
        }
    }
    __syncthreads();
}

struct Args { const float* in[17]; float* out; unsigned char* ws; };

__global__ void __launch_bounds__(NTHREADS, 2) mega_fwd(Args args) {
    extern __shared__ __attribute__((aligned(16))) unsigned char lds_raw[];
    LAS unsigned char* lds = (LAS unsigned char*)lds_raw;
    cg::grid_group grid = cg::this_grid();
    const int G = gridDim.x, blk = blockIdx.x, NGW = G * 8;
#define FRESH_IDS() const int tid = fresh_tid(), lane = tid & 63, wave = __builtin_amdgcn_readfirstlane(tid >> 6), gw = blk * 8 + wave; (void)lane; (void)gw
    const float* x = args.in[0]; float* out = args.out;
    bf16_t* Wb = (bf16_t*)(args.ws + WS_W);
    bf16_t* U = (bf16_t*)(args.ws + WS_U);
    bf16_t* Z = (bf16_t*)(args.ws + WS_BIG);
    bf16_t* MRG = (bf16_t*)(args.ws + WS_BIG + 288 * MiB);
    float* SSQ = (float*)(args.ws + WS_SSQ);
    bf16_t* ACT = (bf16_t*)(args.ws + WS_BIG);
    float* PRE = (float*)(args.ws + WS_BIG + 176 * MiB);

    volatile LAS unsigned* MISC = (volatile LAS unsigned*)(lds + LDS_BYTES - 64);
    unsigned* barw = (unsigned*)(args.ws + WS_BAR);
    { FRESH_IDS(); if (tid < 16) MISC[tid] = 0u;
    }
    __syncthreads();
    const XcdBarrier xbar = xcd_barrier_post(barw, MISC + 8);
#define GRID_BAR() xcd_barrier(xbar)
    {
        FRESH_IDS();
        LAS float* scr = (LAS float*)(lds + wave * 16384);
        constexpr int I_A = 16 * 64, I_B = 16 * 72, I_G = 16 * 96, I_P = 8 * 32, I_O = 16 * 32, I_UP = 16 * 176, I_DN = 44 * 32;
        constexpr int I_LAYER = I_A + I_B + I_G + 3 * I_P + I_O + I_UP + I_DN;
        for (int it = gw; it < 2 * I_LAYER; it += NGW) {
            const int l = it / I_LAYER; int r = it - l * I_LAYER;
            bf16_t* WL = Wb + (size_t)l * LAYER_W;
            const float* w_in = args.in[2] + (size_t)l * DM * DIN;
            if (r < I_A) { transpose_item(w_in, DIN, 2048, WL + OW_IN, DM, 0, scr, r, lane, args.in[1] + l * DM); continue; } r -= I_A;
            if (r < I_B) { transpose_item(w_in + 2064, DIN, 2304, WL + OW_IN, DM, 2048, scr, r, lane, args.in[1] + l * DM); continue; } r -= I_B;
            if (r < I_G) { transpose_item(w_in + 4368, DIN, 3072, WL + OW_G, DM, 0, scr, r, lane, args.in[1] + l * DM); continue; } r -= I_G;
            if (r < I_P) { transpose_item(args.in[8] + (size_t)l * 512 * DM, DM, DM, WL + OW_GLA, 512, 0, scr, r, lane); continue; } r -= I_P;
            if (r < I_P) { transpose_item(args.in[9] + (size_t)l * 512 * DM, DM, DM, WL + OW_CONV, 512, 0, scr, r, lane); continue; } r -= I_P;
            if (r < I_P) { transpose_item(args.in[10] + (size_t)l * 512 * DM, DM, DM, WL + OW_SWA, 512, 0, scr, r, lane); continue; } r -= I_P;
            if (r < I_O) { transpose_item(args.in[11] + (size_t)l * DM * DM, DM, DM, WL + OW_O, DM, 0, scr, r, lane); continue; } r -= I_O;
            if (r < I_UP) { transpose_item<true>(args.in[13] + (size_t)l * DM * DFF2, DFF2, DFF2, WL + OW_UP, DM, 0, scr, r, lane, args.in[12] + l * DM); continue; } r -= I_UP;
            transpose_item(args.in[15] + (size_t)l * DFF * DM, DM, DM, WL + OW_DN, DFF, 0, scr, r, lane);
        }
        for (int idx = blk * NTHREADS + tid; idx < 2 * 256 * DM; idx += G * NTHREADS) {
            const int l = idx / (256 * DM), rem = idx - l * 256 * DM, row = rem >> 10, k = rem & 1023;
            const float v = row < 16 ? args.in[2][(size_t)l * DM * DIN + (size_t)k * DIN + 2048 + row] * args.in[1][l * DM + k] : 0.f;
            Wb[(size_t)l * LAYER_W + OW_IN + (size_t)(4352 + row) * DM + k] = (bf16_t)f2bf(v);
        }
        for (int m = gw; m < T; m += 4 * NGW) {
            f32x4 v[4][4]; float sq[4];
#pragma unroll
            for (int h4 = 0; h4 < 4; ++h4) { const int mm = m + h4 * NGW; const f32x4* xr = (const f32x4*)(x + (size_t)(mm < T ? mm : m) * DM) + lane;
#pragma unroll
                for (int j = 0; j < 4; ++j) v[h4][j] = xr[64 * j]; }
#pragma unroll
            for (int h4 = 0; h4 < 4; ++h4) { float q = 0.f;
#pragma unroll
                for (int j = 0; j < 4; ++j) q += (v[h4][j].x * v[h4][j].x + v[h4][j].y * v[h4][j].y) + (v[h4][j].z * v[h4][j].z + v[h4][j].w * v[h4][j].w);
                sq[h4] = q; }
#pragma unroll
            for (int o = 1; o < 64; o <<= 1) {
#pragma unroll
                for (int h4 = 0; h4 < 4; ++h4) sq[h4] += __shfl_xor(sq[h4], o); }
#pragma unroll
            for (int h4 = 0; h4 < 4; ++h4) { const int mm = m + h4 * NGW; if (mm < T) {
                unsigned long long* o8 = (unsigned long long*)(U + (size_t)mm * DM) + lane;
#pragma unroll
                for (int j = 0; j < 4; ++j) o8[64 * j] = (unsigned long long)pk2(v[h4][j].x, v[h4][j].y) | ((unsigned long long)pk2(v[h4][j].z, v[h4][j].w) << 32);
                if (lane < 4) *(f32x4*)(SSQ + ((size_t)lane * T + mm) * 4) = (f32x4){lane == 0 ? sq[h4] : 0.f, 0.f, 0.f, 0.f}; } }
        }
    }
    GRID_BAR();
    if (G == 0x7fffffff) grid.sync();

    for (int l = 0; l < 2; ++l) {
        const bf16_t* WL = Wb + (size_t)l * LAYER_W;
        {
            pg8::Gemm g{U, U, U, WL + OW_IN, WL + OW_IN, WL + OW_IN};
            pg8::StaticOrder<1, ZLD> S; S.init(G, blk);
            pg8::EpiBf16<0> E{Z, ZLD, SSQ};
            if (PHM & 16) pg8::gemm_phase<pg8::EpiBf16<0>, pg8::StaticOrder<1, ZLD>, 1, DM, DM, DM>(lds, g, S, E);
        }
        GRID_BAR();
        {
            float* Sbuf = (float*)(args.ws + WS_SBUF); float* Btot = (float*)(args.ws + WS_BTOT);
            if (PHM & 1) for (int u = blk; u < 256; u += G) gla_segment<false>(lds, Z, args.in[3] + (size_t)l * 16 * 512, args.in[4] + (size_t)l * 512, args.in[5] + (size_t)l * 512, u, Sbuf, Btot);
            for (int u = blk; u < NB * 32 * 2; u += G) { const int kvh = u & 1, qb = (u >> 1) & 31, b = u >> 6; if (PHM & 2) swa_unit(lds, Z, args.in[7] + l * 8, b, qb, kvh); }
        }
        GRID_BAR();
        {
            float* Sbuf = (float*)(args.ws + WS_SBUF); float* Btot = (float*)(args.ws + WS_BTOT);
            if (PHM & 1) for (int u = blk; u < 256; u += G) gla_segment<true>(lds, Z, args.in[3] + (size_t)l * 16 * 512, args.in[4] + (size_t)l * 512, args.in[5] + (size_t)l * 512, u, Sbuf, Btot);
            FRESH_IDS();
            const float* cw = args.in[6] + (size_t)l * 3 * 512;
            if (PHM & 4) for (int it = blk * NTHREADS + tid; it < (T / 4) * 64; it += G * NTHREADS) {
                const int tg = it >> 6, c8 = it & 63, t0 = tg * 4; const bool has_prev = (t0 & (SEQ - 1)) != 0;
                bf16_t* zp = Z + (size_t)t0 * ZLD + c8 * 8;
                const u32x4 z4 = (u32x4){0u, 0u, 0u, 0u};
                u32x4 xm2 = z4, cm2 = z4, xm1 = z4, cm1 = z4, xr[4], cr[4], br[4];
                if (has_prev) { xm2 = *(const u32x4*)(zp - 2 * ZLD + ZCX); cm2 = *(const u32x4*)(zp - 2 * ZLD + ZCC); xm1 = *(const u32x4*)(zp - ZLD + ZCX); cm1 = *(const u32x4*)(zp - ZLD + ZCC); }
#pragma unroll
                for (int q = 0; q < 4; ++q) { xr[q] = *(const u32x4*)(zp + (size_t)q * ZLD + ZCX); cr[q] = *(const u32x4*)(zp + (size_t)q * ZLD + ZCC); br[q] = *(const u32x4*)(zp + (size_t)q * ZLD + ZCB); }
                float w0[8], w1[8], w2[8], p2[8], p1[8];
#pragma unroll
                for (int e = 0; e < 8; ++e) { w0[e] = cw[c8 * 8 + e]; w1[e] = cw[512 + c8 * 8 + e]; w2[e] = cw[1024 + c8 * 8 + e]; }
#pragma unroll
                for (int e = 0; e < 4; ++e) { p2[2 * e] = bflo(xm2[e]) * bflo(cm2[e]); p2[2 * e + 1] = bfhi(xm2[e]) * bfhi(cm2[e]); p1[2 * e] = bflo(xm1[e]) * bflo(cm1[e]); p1[2 * e + 1] = bfhi(xm1[e]) * bfhi(cm1[e]); }
#pragma unroll
                for (int q = 0; q < 4; ++q) { float p0[8]; unsigned res[4];
#pragma unroll
                    for (int e = 0; e < 4; ++e) { p0[2 * e] = bflo(xr[q][e]) * bflo(cr[q][e]); p0[2 * e + 1] = bfhi(xr[q][e]) * bfhi(cr[q][e]); }
#pragma unroll
                    for (int e = 0; e < 4; ++e) {
                        const float lo = bflo(br[q][e]) * (w0[2 * e] * p2[2 * e] + w1[2 * e] * p1[2 * e] + w2[2 * e] * p0[2 * e]);
                        const float hi = bfhi(br[q][e]) * (w0[2 * e + 1] * p2[2 * e + 1] + w1[2 * e + 1] * p1[2 * e + 1] + w2[2 * e + 1] * p0[2 * e + 1]);
                        res[e] = pk2(lo, hi); }
                    *(u32x4*)(zp + (size_t)q * ZLD + ZCB) = (u32x4){res[0], res[1], res[2], res[3]};
#pragma unroll
                    for (int e = 0; e < 8; ++e) { p2[e] = p1[e]; p1[e] = p0[e]; } }
            }
        }
        GRID_BAR();
        {
            pg8::Gemm g{U, U, U, WL + OW_G, WL + OW_G, WL + OW_G};
            pg8::StaticOrder<1, 3072> S; S.init(G, blk);
            pg8::EpiBf16<1> E{Z, ZLD, SSQ};
            if (PHM & 32) pg8::gemm_phase<pg8::EpiBf16<1>, pg8::StaticOrder<1, 3072>, 1, DM, DM, DM>(lds, g, S, E);
        }
        GRID_BAR();
        {
            pg8::Gemm g{Z + ZR, Z + ZCB, Z + ZSQ, WL + OW_GLA, WL + OW_CONV, WL + OW_SWA};
            pg8::StaticOrder<3, DM> S; S.init(G, blk);
            pg8::EpiMerge E{Z, MRG, DM};
            if (PHM & 64) pg8::gemm_phase<pg8::EpiMerge, pg8::StaticOrder<3, DM>, 3, 512, ZLD, 512>(lds, g, S, E);
        }
        GRID_BAR();
        {
            pg8::Gemm g{MRG, MRG, MRG, WL + OW_O, WL + OW_O, WL + OW_O};
            pg8::StaticOrder<1, DM> S; S.init(G, blk);
            pg8::EpiResid E{(const float*)nullptr, U, (float*)nullptr, DM, U, SSQ};
            if (PHM & 128) pg8::gemm_phase<pg8::EpiResid, pg8::StaticOrder<1, DM>, 1, DM, DM, DM>(lds, g, S, E);
        }
        GRID_BAR();
        {
            pg8::Gemm g{U, U, U, WL + OW_UP, WL + OW_UP, WL + OW_UP};
            pg8::StaticOrder<1, DFF2> S; S.init(G, blk);
            pg8::EpiAct E{ACT, PRE, args.in[14] + (size_t)l * 3 * DFF2, lds + 131072, SSQ};
            if (PHM & 16) pg8::gemm_phase<pg8::EpiAct, pg8::StaticOrder<1, DFF2>, 1, DM, DM, DM>(lds, g, S, E);
        }
        GRID_BAR();
        {
            pg8::Gemm g{ACT, ACT, ACT, WL + OW_DN, WL + OW_DN, WL + OW_DN};
            pg8::StaticOrder<1, DM> S; S.init(G, blk);
            {
                FRESH_IDS();
                const float* fw = args.in[14] + (size_t)l * 3 * DFF2;
                pg8::Unit fu;
                for (int i = 0; S.next(i, fu); ++i) {
                    const int pm = fu.pm; const bool first = (pm & 15) == 0;
                    const float* P0 = PRE + (size_t)pm * 4 * DFF2; const float* Pp = PRE + (size_t)(pm - 1) * 4 * DFF2;
                    float fx0[6][2], fx1[6][2], fm2[6][2], fm1[6][2], fw0[6][2], fw1[6][2], fw2[6][2];
#pragma unroll
                    for (int k = 0; k < 6; ++k) { const int c = tid + k * NTHREADS;
#pragma unroll
                        for (int hbj = 0; hbj < 2; ++hbj) { const int cc = (c < DFF ? c : tid) + hbj * DFF;
                            fx0[k][hbj] = P0[cc]; fx1[k][hbj] = P0[DFF2 + cc]; fm2[k][hbj] = first ? 0.f : Pp[2 * DFF2 + cc]; fm1[k][hbj] = first ? 0.f : Pp[3 * DFF2 + cc];
                            fw0[k][hbj] = fw[cc]; fw1[k][hbj] = fw[DFF2 + cc]; fw2[k][hbj] = fw[2 * DFF2 + cc]; } }
#pragma unroll
                    for (int k = 0; k < 6; ++k) { const int c = tid + k * NTHREADS;
                        if (c < DFF) {
                            const float ra0 = fw0[k][0] * fm2[k][0] + fw1[k][0] * fm1[k][0] + fw2[k][0] * fx0[k][0], ra1 = fw0[k][0] * fm1[k][0] + fw1[k][0] * fx0[k][0] + fw2[k][0] * fx1[k][0];
                            const float rb0 = fw0[k][1] * fm2[k][1] + fw1[k][1] * fm1[k][1] + fw2[k][1] * fx0[k][1], rb1 = fw0[k][1] * fm1[k][1] + fw1[k][1] * fx0[k][1] + fw2[k][1] * fx1[k][1];
                            ACT[(size_t)(pm * 256) * DFF + c] = (bf16_t)f2bf(siluf_(ra0) * rb0);
                            ACT[(size_t)(pm * 256 + 1) * DFF + c] = (bf16_t)f2bf(siluf_(ra1) * rb1); } }
                }
                asm volatile("s_waitcnt vmcnt(0)" ::: "memory");
                __syncthreads();
                __builtin_amdgcn_fence(__ATOMIC_ACQUIRE, "agent");
            }
            pg8::EpiResid E{(const float*)nullptr, U, (float*)nullptr, DM, U, SSQ};
            if (PHM & 128) pg8::gemm_phase<pg8::EpiResid, pg8::StaticOrder<1, DM>, 1, DFF, DFF, DFF>(lds, g, S, E);
        }
        GRID_BAR();
    }
    { FRESH_IDS();
      const f32x4* gr = (const f32x4*)args.in[16] + lane;
      for (int m = gw; m < T; m += 4 * NGW) {
          u32x2 v[4][4]; f32x4 pq[4][4];
#pragma unroll
          for (int h4 = 0; h4 < 4; ++h4) { const int mm = (m + h4 * NGW) < T ? (m + h4 * NGW) : m; const u32x2* hr = (const u32x2*)(U + (size_t)mm * DM) + lane;
#pragma unroll
              for (int j = 0; j < 4; ++j) { v[h4][j] = hr[64 * j]; pq[h4][j] = *(const f32x4*)(SSQ + ((size_t)j * T + mm) * 4); } }
#pragma unroll
          for (int h4 = 0; h4 < 4; ++h4) { const int mm = m + h4 * NGW; if (mm < T) {
              float sq = 0.f;
#pragma unroll
              for (int j = 0; j < 4; ++j) sq += (pq[h4][j].x + pq[h4][j].y) + (pq[h4][j].z + pq[h4][j].w);
              const float rstd = __builtin_amdgcn_rsqf(sq * (1.f / DM) + EPS); f32x4* xw = (f32x4*)(out + (size_t)mm * DM) + lane;
#pragma unroll
              for (int j = 0; j < 4; ++j) { const f32x4 hv = (f32x4){bflo(v[h4][j].x), bfhi(v[h4][j].x), bflo(v[h4][j].y), bfhi(v[h4][j].y)}; xw[64 * j] = hv * rstd * gr[64 * j]; } } }
      }
    }
}

extern "C" void kernel_launch(void* const* d_in, const int* in_sizes, int n_in, void* d_out, int out_size, void* d_ws, size_t ws_size, hipStream_t stream) {
    static int grid_blocks = 0;
    if (grid_blocks == 0) {
        if (n_in != 17 || out_size != T * DM || ws_size < WS_END) { fprintf(stderr, "kernel_launch: unexpected shapes (n_in %d out %d ws %zu)\n", n_in, out_size, ws_size); grid_blocks = -1; return; }
        int dev = 0, cus = 0, per_cu = 0;
        hipGetDevice(&dev);
        hipDeviceGetAttribute(&cus, hipDeviceAttributeMultiprocessorCount, dev);
        if (hipFuncSetAttribute((const void*)mega_fwd, hipFuncAttributeMaxDynamicSharedMemorySize, LDS_BYTES) != hipSuccess) { fprintf(stderr, "kernel_launch: hipFuncSetAttribute failed\n"); grid_blocks = -1; return; }
        if (hipOccupancyMaxActiveBlocksPerMultiprocessor(&per_cu, (const void*)mega_fwd, NTHREADS, LDS_BYTES) != hipSuccess || per_cu < 1) { fprintf(stderr, "kernel_launch: occupancy query says %d\n", per_cu); per_cu = 1; }
        (void)hipGetLastError();
        grid_blocks = cus * (per_cu > 1 ? 1 : per_cu);
        fprintf(stderr, "kernel_launch: grid %d (cus %d, per_cu %d), ws %zu\n", grid_blocks, cus, per_cu, ws_size);
    }
    if (grid_blocks < 0) return;
    Args a{};
    for (int i = 0; i < 17; ++i) a.in[i] = (const float*)d_in[i];
    a.out = (float*)d_out; a.ws = (unsigned char*)d_ws;
    void* kargs[] = {&a};
    if (hipMemsetAsync((unsigned char*)d_ws + WS_BAR, 0, XCD_BAR_WORDS * 4, stream) != hipSuccess) { fprintf(stderr, "kernel_launch: memset of the barrier words failed\n"); return; }
    hipError_t e = hipLaunchCooperativeKernel((const void*)mega_fwd, dim3(grid_blocks), dim3(NTHREADS), kargs, LDS_BYTES, stream);
    if (e != hipSuccess) fprintf(stderr, "kernel_launch: cooperative launch failed: %s (grid %d)\n", hipGetErrorString(e), grid_blocks);
}
```

```cpp
#include <hip/hip_runtime.h>
#include <hip/hip_cooperative_groups.h>
#include <cstdio>
#include <cstdint>
#include <cmath>
namespace cg = cooperative_groups;

#define LAS __attribute__((address_space(3)))
typedef unsigned short bf16_t;
typedef short bf16x8 __attribute__((ext_vector_type(8)));
typedef float f32x4 __attribute__((ext_vector_type(4)));
typedef float f32x2 __attribute__((ext_vector_type(2)));
typedef unsigned u32x4 __attribute__((ext_vector_type(4)));
typedef unsigned u32x2 __attribute__((ext_vector_type(2)));

constexpr int NB = 8, SEQ = 4096, T = NB * SEQ, DM = 1024, DIN = 7440, DFF = 2816, DFF2 = 5632;
constexpr int ZLD = 4608;
constexpr int ZQ = 0, ZK = 512, ZV = 1024, ZR = 1536, ZCX = 2048, ZCB = 2560, ZCC = 3072, ZSQ = 3584, ZSK = 4096, ZSV = 4224, ZGA = 4352;
constexpr float EPS = 1e-6f;
constexpr size_t OW_IN = 0, OW_G = 4718592, OW_GLA = 7864320, OW_CONV = 8388608, OW_SWA = 8912896, OW_O = 9437184, OW_UP = 10485760, OW_DN = 16252928, LAYER_W = 19136512;
constexpr size_t MiB = 1u << 20;
constexpr size_t WS_W = 0, WS_BTOT = 76 * MiB, WS_BAR = 77 * MiB, WS_SSQ = 78 * MiB, WS_U = 80 * MiB, WS_BIG = 144 * MiB, WS_SBUF = 496 * MiB, WS_END = 512 * MiB;
static_assert(2 * LAYER_W * 2 <= WS_BTOT, "weights fit");
constexpr int LDS_BYTES = 147456;
constexpr int NTHREADS = 512;
#ifndef PHM
#define PHM 0xffff
#endif

__device__ __forceinline__ unsigned f2bf(float f) { unsigned u = __builtin_bit_cast(unsigned, f); return (u + 0x7fffu + ((u >> 16) & 1u)) >> 16; }
__device__ __forceinline__ unsigned pk2(float lo, float hi) { return f2bf(lo) | (f2bf(hi) << 16); }
__device__ __forceinline__ float bf2f(bf16_t h) { return __builtin_bit_cast(float, (unsigned)h << 16); }
__device__ __forceinline__ float bflo(unsigned w) { return __builtin_bit_cast(float, w << 16); }
__device__ __forceinline__ float bfhi(unsigned w) { return __builtin_bit_cast(float, w & 0xffff0000u); }
__device__ __forceinline__ unsigned cvt_pk_bf16(float lo, float hi) { unsigned r; asm volatile("s_nop 1\n\tv_cvt_pk_bf16_f32 %0, %1, %2" : "=v"(r) : "v"(lo), "v"(hi)); return r; }
__device__ __forceinline__ unsigned hwbf(float f) { return cvt_pk_bf16(f, 0.f) & 0xffffu; }
__device__ __forceinline__ float wave_sum(float v) {
#pragma unroll
    for (int o = 1; o < 64; o <<= 1) v += __shfl_xor(v, o);
    return v;
}
__device__ __forceinline__ float sigmoidf_(float x) { return __builtin_amdgcn_rcpf(1.0f + __expf(-x)); }
__device__ __forceinline__ float siluf_(float x) { return x * __builtin_amdgcn_rcpf(1.0f + __expf(-x)); }
#define LDS_WAIT() asm volatile("s_waitcnt lgkmcnt(0)" ::: "memory")
__device__ __forceinline__ int fresh_tid() { int t = threadIdx.x; asm volatile("" : "+v"(t)); return t; }

namespace pg8 {
constexpr int BM = 256, BK = 64, HALF = 128, HTB = HALF * BK * 2, STAGE_BYTES = 8 * HTB, NXCD = 8, WGM = 8;
__host__ __device__ __forceinline__ int lds_byte(int r, int c) { const int st = (r >> 4) * 2 + (c >> 5), rr = r & 15, cc = c & 31, ob = rr * 64 + cc * 2; return st * 1024 + (ob ^ (((ob >> 9) & 1) << 5)); }
__host__ __device__ __forceinline__ void stage_rc(int b, int& R, int& C) { const int st = b / 1024, sb = b % 1024, swz = sb ^ (((sb >> 9) & 1) << 5); R = (st >> 1) * 16 + swz / 64; C = (st & 1) * 32 + (swz % 64) / 2; }
__host__ __device__ __forceinline__ int perm32(int rho) { const int n = rho >> 4, i = rho & 15; return 8 * (i >> 2) + 4 * n + (i & 3); }

struct Unit { int pm, pn, seg; };
struct Gemm { const bf16_t* A0; const bf16_t* A1; const bf16_t* A2; const bf16_t* B0; const bf16_t* B1; const bf16_t* B2; };

template <int NSEG, int N_> struct StaticOrder {
    static constexpr int nM = T / BM, nN = N_ / BM, nwg = nM * nN;
    int G, c;
    __device__ __forceinline__ void init(int G_, int c_) { G = G_; c = c_; }
    __device__ __forceinline__ bool next(int i, Unit& u) const {
        const int ti = (NSEG == 1) ? i : i / NSEG; u.seg = (NSEG == 1) ? 0 : i - ti * NSEG;
        const long L = (long)ti * G + c; if (L >= nwg) return false;
        int wgid = (int)L; { const int q = nwg / NXCD, r = nwg % NXCD, xcd = wgid % NXCD, off = wgid / NXCD; wgid = (xcd < r ? xcd * (q + 1) : r * (q + 1) + (xcd - r) * q) + off; }
        const int nig = WGM * nN, gid = wgid / nig, fm = gid * WGM, gsz = (nM - fm) < WGM ? (nM - fm) : WGM;
        u.pm = fm + ((wgid % nig) % gsz); u.pn = (wgid % nig) / gsz; return true;
    }
};


__device__ __forceinline__ void scale_rows(f32x4 (&acc)[2][2][4][2], const float* ssq, const Unit& u, int wr, int fr, int fq, float mul = 1.0f) {
    f32x4 p[2][4];
#pragma unroll
    for (int ai = 0; ai < 2; ++ai)
#pragma unroll
        for (int m = 0; m < 4; ++m) { const size_t r = (size_t)(u.pm * BM + ai * HALF + wr * 64 + m * 16 + fr); p[ai][m] = *(const f32x4*)(ssq + ((size_t)fq * T + r) * 4); }
#pragma unroll
    for (int ai = 0; ai < 2; ++ai)
#pragma unroll
        for (int m = 0; m < 4; ++m) { float sq = (p[ai][m].x + p[ai][m].y) + (p[ai][m].z + p[ai][m].w);
            sq += __shfl_xor(sq, 16); sq += __shfl_xor(sq, 32);
            const float rs = __builtin_amdgcn_rsqf(sq * (1.0f / DM) + EPS) * mul;
#pragma unroll
            for (int bj = 0; bj < 2; ++bj)
#pragma unroll
                for (int n = 0; n < 2; ++n) acc[ai][bj][m][n] = acc[ai][bj][m][n] * rs; }
}

template <int MODE  > struct EpiBf16 {
    static constexpr bool PERM = true;
    bf16_t* O; int ldc; const float* ssq;
    __device__ __forceinline__ bool keep(const Unit&) const { return false; }
    __device__ __forceinline__ static int gate_zcol(int tile) {
        return tile < 4 ? tile * 256 : tile < 6 ? 1024 + (tile - 4) * 256 : tile < 8 ? ZCX + (tile - 6) * 256 : tile < 10 ? ZCC + (tile - 8) * 256 : tile == 10 ? ZSK : ZGA;
    }
    __device__ __forceinline__ void operator()(f32x4 (&acc)[2][2][4][2], const Unit& u, int wr, int wc, int fr, int fq) const {
        scale_rows(acc, ssq, u, wr, fr, fq, MODE == 1 ? -1.4426950408889634f : 1.0f);
        const int row0 = u.pm * BM + wr * 64 + fr;
        const int colt = (MODE == 1) ? gate_zcol(u.pn) : u.pn * BM;
        const int col0 = colt + wc * 32 + 8 * fq;
#pragma unroll
        for (int ai = 0; ai < 2; ++ai)
#pragma unroll
            for (int m = 0; m < 4; ++m) { bf16_t* rowp = O + (size_t)(row0 + ai * HALF + m * 16) * ldc + col0;
#pragma unroll
                for (int bj = 0; bj < 2; ++bj) { f32x4 v0 = acc[ai][bj][m][0], v1 = acc[ai][bj][m][1];
                    if (MODE == 1) {
                        unsigned g0 = 0u, g1 = 0u;
#pragma unroll
                        for (int e = 0; e < 4; ++e) { g0 = __builtin_amdgcn_cvt_pk_u8_f32(fmaxf(floorf(255.f * __builtin_amdgcn_rcpf(1.0f + __builtin_amdgcn_exp2f(v0[e])) + 0.5f), 1.f), e, g0);
                                                      g1 = __builtin_amdgcn_cvt_pk_u8_f32(fmaxf(floorf(255.f * __builtin_amdgcn_rcpf(1.0f + __builtin_amdgcn_exp2f(v1[e])) + 0.5f), 1.f), e, g1); }
                        *(u32x2*)((unsigned char*)O + ((size_t)(row0 + ai * HALF + m * 16) * ldc + colt) * 2 + bj * HALF + wc * 32 + 8 * fq) = (u32x2){g0, g1};
                    } else {
                    if (u.pn * BM + bj * HALF + wc * 32 + 8 * fq < ZGA + 16) {
                    u32x4 w; w.x = cvt_pk_bf16(v0[0], v0[1]); w.y = cvt_pk_bf16(v0[2], v0[3]); w.z = cvt_pk_bf16(v1[0], v1[1]); w.w = cvt_pk_bf16(v1[2], v1[3]);
                    *(u32x4*)(rowp + bj * HALF) = w; } } } }
    }
};

struct EpiMerge {
    static constexpr bool PERM = true;
    const bf16_t* Zg; bf16_t* O; int ldc;
    __device__ __forceinline__ bool keep(const Unit& u) const { return u.seg != 2; }
    __device__ __forceinline__ void operator()(f32x4 (&acc)[2][2][4][2], const Unit& u, int wr, int wc, int fr, int fq) const {
        const int row0 = u.pm * BM + wr * 64 + fr;
        const int seg = u.seg;
        const int gnum = EpiBf16<1>::gate_zcol(4 * seg + u.pn) * 2 + wc * 32 + 8 * fq;
        const int gden = EpiBf16<1>::gate_zcol(4 * (seg < 2 ? seg + 1 : 2) + u.pn) * 2 + wc * 32 + 8 * fq;
        const int col0 = u.pn * BM + wc * 32 + 8 * fq;
        const unsigned char* Zb = (const unsigned char*)Zg;
        u32x2 gnv[2][4][2], gdv[2][4][2];
#pragma unroll
        for (int ai = 0; ai < 2; ++ai)
#pragma unroll
            for (int m = 0; m < 4; ++m) { const size_t r = (size_t)(row0 + ai * HALF + m * 16);
#pragma unroll
                for (int bj = 0; bj < 2; ++bj) { gnv[ai][m][bj] = *(const u32x2*)(Zb + r * (ZLD * 2) + gnum + bj * HALF);
                    gdv[ai][m][bj] = (seg < 2) ? *(const u32x2*)(Zb + r * (ZLD * 2) + gden + bj * HALF) : (u32x2){0u, 0u}; } }
#pragma unroll
        for (int ai = 0; ai < 2; ++ai) {
#pragma unroll
            for (int m = 0; m < 4; ++m) { const size_t r = (size_t)(row0 + ai * HALF + m * 16);
#pragma unroll
                for (int bj = 0; bj < 2; ++bj) {
                    const u32x2 gn = gnv[ai][m][bj], gd = gdv[ai][m][bj];
                    float f[8];
#pragma unroll
                    for (int e = 0; e < 4; ++e) { f[e] = (float)((gn.x >> (8 * e)) & 0xffu); f[4 + e] = (float)((gn.y >> (8 * e)) & 0xffu); }
                    if (seg < 2) {
#pragma unroll
                        for (int e = 0; e < 4; ++e) { f[e] = f[e] * __builtin_amdgcn_rcpf((float)((gd.x >> (8 * e)) & 0xffu)); f[4 + e] = f[4 + e] * __builtin_amdgcn_rcpf((float)((gd.y >> (8 * e)) & 0xffu)); }
                    } else {
#pragma unroll
                        for (int e = 0; e < 8; ++e) f[e] = f[e] * (1.0f / 255.0f);
                    }
                    f32x4 v0 = acc[ai][bj][m][0], v1 = acc[ai][bj][m][1];
#pragma unroll
                    for (int e = 0; e < 4; ++e) { v0[e] *= f[e]; v1[e] *= f[4 + e]; }
                    acc[ai][bj][m][0] = v0; acc[ai][bj][m][1] = v1;
                    if (seg == 2) {
                        u32x4 w; w.x = cvt_pk_bf16(v0[0], v0[1]); w.y = cvt_pk_bf16(v0[2], v0[3]); w.z = cvt_pk_bf16(v1[0], v1[1]); w.w = cvt_pk_bf16(v1[2], v1[3]);
                        *(u32x4*)(O + r * ldc + col0 + bj * HALF) = w;
                    }
                } }
        }
    }
};

#define DPPF(v, ctrl) __builtin_bit_cast(float, __builtin_amdgcn_update_dpp(0, __builtin_bit_cast(int, (v)), (ctrl), 0xf, 0xf, true))
struct EpiAct {
    static constexpr bool PERM = true;
    bf16_t* ACT; float* PRE; const float* fw; LAS unsigned char* xch; const float* ssq;
    __device__ __forceinline__ bool keep(const Unit&) const { return false; }
    __device__ __forceinline__ void operator()(f32x4 (&acc)[2][2][4][2], const Unit& u, int wr, int wc, int fr, int fq) const {
        LAS float* X = (LAS float*)xch;
        const int chb = u.pn * 128 + wc * 32 + 8 * fq;
        f32x4 wq[3][2];
#pragma unroll
        for (int k = 0; k < 3; ++k)
#pragma unroll
            for (int bj = 0; bj < 2; ++bj) wq[k][bj] = *(const f32x4*)(fw + k * DFF2 + bj * DFF + chb);
        {
            LAS float* RS = X + 2048;
            const int lane_e = fq * 16 + fr;
            if (lane_e < 32) { const int rr = (wr * 4 + wc) * 32 + lane_e; const float* sp = ssq + (size_t)(u.pm * BM + rr) * 4;
                const f32x4 a0 = *(const f32x4*)sp, a1 = *(const f32x4*)(sp + (size_t)T * 4), a2 = *(const f32x4*)(sp + (size_t)T * 8), a3 = *(const f32x4*)(sp + (size_t)T * 12);
                const float sq = ((a0.x + a0.y) + (a0.z + a0.w)) + ((a1.x + a1.y) + (a1.z + a1.w)) + ((a2.x + a2.y) + (a2.z + a2.w)) + ((a3.x + a3.y) + (a3.z + a3.w));
                RS[rr] = __builtin_amdgcn_rsqf(sq * (1.0f / DM) + EPS); }
            asm volatile("s_waitcnt lgkmcnt(0)" ::: "memory"); __builtin_amdgcn_s_barrier(); asm volatile("" ::: "memory");
#pragma unroll
            for (int ai = 0; ai < 2; ++ai)
#pragma unroll
                for (int m = 0; m < 4; ++m) { const float rs = RS[ai * HALF + wr * 64 + m * 16 + fr];
#pragma unroll
                    for (int bj = 0; bj < 2; ++bj)
#pragma unroll
                        for (int n = 0; n < 2; ++n) acc[ai][bj][m][n] = acc[ai][bj][m][n] * rs; }
        }
        if (fr >= 14) {
#pragma unroll
            for (int ai = 0; ai < 2; ++ai) { LAS float* p = X + ((((ai * 2 + wr) * 4 + wc) * 2 + (fr - 14)) * 4 + fq) * 16;
#pragma unroll
                for (int bj = 0; bj < 2; ++bj)
#pragma unroll
                    for (int n = 0; n < 2; ++n) *(LAS f32x4*)(p + bj * 8 + n * 4) = acc[ai][bj][3][n]; }
            if (wr == 1) { float* q = PRE + ((size_t)u.pm * 4 + 2 + (fr - 14)) * DFF2 + chb;
#pragma unroll
                for (int bj = 0; bj < 2; ++bj)
#pragma unroll
                    for (int n = 0; n < 2; ++n) *(f32x4*)(q + bj * DFF + 4 * n) = acc[1][bj][3][n]; }
        }
        if (wr == 0 && fr < 2) { float* q = PRE + ((size_t)u.pm * 4 + fr) * DFF2 + chb;
#pragma unroll
            for (int bj = 0; bj < 2; ++bj)
#pragma unroll
                for (int n = 0; n < 2; ++n) *(f32x4*)(q + bj * DFF + 4 * n) = acc[0][bj][0][n]; }
        asm volatile("s_waitcnt lgkmcnt(0)" ::: "memory"); __builtin_amdgcn_s_barrier(); asm volatile("" ::: "memory");
#pragma unroll
        for (int n = 0; n < 2; ++n) {
            f32x4 w[3][2];
#pragma unroll
            for (int k = 0; k < 3; ++k)
#pragma unroll
                for (int bj = 0; bj < 2; ++bj) w[k][bj] = (n == 0) ? wq[k][bj] : *(const f32x4*)(fw + k * DFF2 + bj * DFF + chb + 4);
#pragma unroll
            for (int ai = 0; ai < 2; ++ai)
#pragma unroll
                for (int m = 0; m < 4; ++m) {
                    f32x4 t1[2], t2[2];
                    if (m > 0) {
#pragma unroll
                        for (int bj = 0; bj < 2; ++bj)
#pragma unroll
                            for (int e = 0; e < 4; ++e) { const float pv = acc[ai][bj][m - 1][n][e]; t1[bj][e] = DPPF(pv, 0x10F); t2[bj][e] = DPPF(pv, 0x10E); }
                    } else {
                        const bool has_pred = (wr == 1) || (ai == 1);
                        const int pai = (wr == 1) ? ai : 0, pwr = (wr == 1) ? 0 : 1;
                        const LAS float* p14 = X + ((((pai * 2 + pwr) * 4 + wc) * 2 + 0) * 4 + fq) * 16; const LAS float* p15 = p14 + 64;
#pragma unroll
                        for (int bj = 0; bj < 2; ++bj) { const f32x4 r14 = *(const LAS f32x4*)(p14 + bj * 8 + n * 4), r15 = *(const LAS f32x4*)(p15 + bj * 8 + n * 4);
#pragma unroll
                            for (int e = 0; e < 4; ++e) { t1[bj][e] = (has_pred && fr == 0) ? r15[e] : 0.f; t2[bj][e] = has_pred ? (fr == 0 ? r14[e] : (fr == 1 ? r15[e] : 0.f)) : 0.f; } }
                    }
                    float h[2][4];
#pragma unroll
                    for (int bj = 0; bj < 2; ++bj)
#pragma unroll
                        for (int e = 0; e < 4; ++e) { const float cur = acc[ai][bj][m][n][e];
                            const float p1 = DPPF(cur, 0x111) + t1[bj][e], p2 = DPPF(cur, 0x112) + t2[bj][e];
                            h[bj][e] = w[0][bj][e] * p2 + w[1][bj][e] * p1 + w[2][bj][e] * cur; }
                    float r4[4];
#pragma unroll
                    for (int c = 0; c < 4; ++c) r4[c] = siluf_(h[0][c]) * h[1][c];
                    const bool skip = (ai == 0) && (m == 0) && (wr == 0) && (fr < 2);
                    if (!skip) { u32x2 o; o.x = cvt_pk_bf16(r4[0], r4[1]); o.y = cvt_pk_bf16(r4[2], r4[3]);
                        *(u32x2*)(ACT + (size_t)(u.pm * BM + ai * HALF + wr * 64 + m * 16 + fr) * DFF + chb + 4 * n) = o; }
                }
            asm volatile("" ::: "memory");
        }
    }
};

struct EpiResid {
    static constexpr bool PERM = false;
    const float* basef; const bf16_t* baseb; float* out; int ldc; bf16_t* hb; float* ssq;
    __device__ __forceinline__ bool keep(const Unit&) const { return false; }
    __device__ __forceinline__ void operator()(f32x4 (&acc)[2][2][4][2], const Unit& u, int wr, int wc, int fr, int fq) const {
        const int col0 = u.pn * BM + wc * 32 + 4 * fq;
#pragma unroll
        for (int ai = 0; ai < 2; ++ai) {
            u32x2 bb[4][2][2];
            if (!basef) {
#pragma unroll
                for (int m = 0; m < 4; ++m) { const size_t off = (size_t)(u.pm * BM + ai * HALF + wr * 64 + m * 16 + fr) * ldc + col0;
#pragma unroll
                    for (int bj = 0; bj < 2; ++bj)
#pragma unroll
                        for (int n = 0; n < 2; ++n) bb[m][bj][n] = *(const u32x2*)(baseb + off + bj * HALF + n * 16); }
            }
#pragma unroll
            for (int m = 0; m < 4; ++m) { const size_t row = (size_t)(u.pm * BM + ai * HALF + wr * 64 + m * 16 + fr); const size_t off = row * ldc + col0; float sq = 0.f;
#pragma unroll
                for (int bj = 0; bj < 2; ++bj)
#pragma unroll
                    for (int n = 0; n < 2; ++n) { f32x4 bs;
                        if (basef) bs = *(const f32x4*)(basef + off + bj * HALF + n * 16);
                        else { const u32x2 b2 = bb[m][bj][n]; bs = (f32x4){bflo(b2.x), bfhi(b2.x), bflo(b2.y), bfhi(b2.y)}; }
                        const f32x4 v = bs + acc[ai][bj][m][n];
                        if (out) *(f32x4*)(out + off + bj * HALF + n * 16) = v;
                        if (hb) { sq += (v.x * v.x + v.y * v.y) + (v.z * v.z + v.w * v.w); *(u32x2*)(hb + off + bj * HALF + n * 16) = (u32x2){cvt_pk_bf16(v.x, v.y), cvt_pk_bf16(v.z, v.w)}; } }
                if (hb) { sq += __shfl_xor(sq, 16); sq += __shfl_xor(sq, 32); if (fq == 0) ssq[((size_t)u.pn * T + row) * 4 + wc] = sq; } }
            asm volatile("" ::: "memory");
        }
    }
};

template <class Epi, class Sched, int NSEG, int KK, int LDA, int LDB>
__device__ __forceinline__ void gemm_phase(LAS unsigned char* lds, const Gemm g, const Sched& S, const Epi& E) {
    const int tid = fresh_tid(), wid = __builtin_amdgcn_readfirstlane(tid >> 6), lane = tid & 63, wr = wid >> 2, wc = wid & 3, fr = lane & 15, fq = lane >> 4;
    constexpr int nt = KK / BK;
    unsigned voffA[2], voffB[2];
#pragma unroll
    for (int i = 0; i < 2; ++i) { int R, C; stage_rc(tid * 16 + i * 8192, R, C); const int Rb = Epi::PERM ? ((R & ~31) + perm32(R & 31)) : R;
        voffA[i] = (unsigned)(R * LDA + C) * 2u; voffB[i] = (unsigned)(Rb * LDB + C) * 2u; }
    constexpr size_t kstep = (size_t)(BK * 2);
    constexpr size_t hstepA = (size_t)HALF * LDA * 2, hstepB = (size_t)HALF * LDB * 2;
    constexpr size_t tstepA = 2 * hstepA, tstepB = 2 * hstepB;
    const unsigned ldsw = (unsigned)wid * 1024u;
    const int aoff = lds_byte(wr * 64 + fr, fq * 8), boff = lds_byte(wc * 32 + fr, fq * 8);
#define PG8_SA(b, h) (((b) * 2 + (h)) * HTB)
#define PG8_SB(b, h) ((4 + (b) * 2 + (h)) * HTB)
#define PG8_STAGE(bufoff, gbase, voff) do { _Pragma("unroll") for (int _i = 0; _i < 2; ++_i) \
        __builtin_amdgcn_global_load_lds((const unsigned*)((const char*)(gbase) + (voff)[_i]), (LAS unsigned*)(lds + (bufoff) + ldsw + _i * 8192), 16, 0, 0); } while (0)
#define PG8_LDA(dst, b, h) do { _Pragma("unroll") for (int m = 0; m < 4; ++m) _Pragma("unroll") for (int k = 0; k < 2; ++k) dst[m][k] = *(const LAS bf16x8*)(lds + PG8_SA(b, h) + aoff + m * 2048 + k * 1024); } while (0)
#define PG8_LDB(dst, b, h) do { _Pragma("unroll") for (int n = 0; n < 2; ++n) _Pragma("unroll") for (int k = 0; k < 2; ++k) dst[n][k] = *(const LAS bf16x8*)(lds + PG8_SB(b, h) + boff + n * 2048 + k * 1024); } while (0)
#define PG8_MMA(ai, bj, At, Bt) do { __builtin_amdgcn_s_setprio(1); _Pragma("unroll") for (int m = 0; m < 4; ++m) _Pragma("unroll") for (int n = 0; n < 2; ++n) _Pragma("unroll") for (int k = 0; k < 2; ++k) \
        acc[ai][bj][m][n] = __builtin_amdgcn_mfma_f32_16x16x32_bf16(Bt[n][k], At[m][k], acc[ai][bj][m][n], 0, 0, 0); __builtin_amdgcn_s_setprio(0); } while (0)
#define PG8_WAIT_V(n) asm volatile("s_waitcnt vmcnt(" #n ")" ::: "memory")
#define PG8_WAIT_L(n) asm volatile("s_waitcnt lgkmcnt(" #n ")" ::: "memory")
#define PG8_BAR __builtin_amdgcn_s_barrier()
#define PG8_SCHED __builtin_amdgcn_sched_barrier(0)
#define PG8_APTR(u) ((const char*)((NSEG == 1 || (u).seg == 0) ? g.A0 : (u).seg == 1 ? g.A1 : g.A2) + (size_t)(u).pm * tstepA)
#define PG8_BPTR(u) ((const char*)((NSEG == 1 || (u).seg == 0) ? g.B0 : (u).seg == 1 ? g.B1 : g.B2) + (size_t)(u).pn * tstepB)
    Unit cur, nxt; int ui = 0;
    if (!S.next(0, cur)) return;
    f32x4 acc[2][2][4][2];
#pragma unroll
    for (int a = 0; a < 2; ++a)
#pragma unroll
        for (int b = 0; b < 2; ++b)
#pragma unroll
            for (int m = 0; m < 4; ++m)
#pragma unroll
                for (int n = 0; n < 2; ++n) acc[a][b][m][n] = (f32x4){0.f, 0.f, 0.f, 0.f};
    bf16x8 At[4][2], B0[2][2], B1[2][2];
    const char* cA = PG8_APTR(cur); const char* cB = PG8_BPTR(cur);
    PG8_STAGE(PG8_SB(0, 0), cB, voffB); PG8_STAGE(PG8_SB(0, 1), cB + hstepB, voffB); PG8_STAGE(PG8_SA(0, 0), cA, voffA); PG8_STAGE(PG8_SA(0, 1), cA + hstepA, voffA);
    if (wr == 1) PG8_BAR;
    PG8_WAIT_V(2); PG8_BAR;
    PG8_STAGE(PG8_SB(1, 0), cB + kstep, voffB); PG8_STAGE(PG8_SA(1, 0), cA + kstep, voffA); PG8_STAGE(PG8_SB(1, 1), cB + hstepB + kstep, voffB);
    PG8_WAIT_V(6); PG8_BAR;
    for (;;) {
        const bool has_next = S.next(ui + 1, nxt);
        const char* nA = has_next ? PG8_APTR(nxt) : cA; const char* nB = has_next ? PG8_BPTR(nxt) : cB;
        for (int t = 0; t < nt; t += 2) {
            const bool last = (t == nt - 2);
            const char* a1 = cA + (size_t)(t + 1) * kstep;
            const char* a2 = last ? nA : cA + (size_t)(t + 2) * kstep; const char* b2 = last ? nB : cB + (size_t)(t + 2) * kstep;
            const char* a3 = a2 + kstep; const char* b3 = b2 + kstep;
            PG8_LDB(B0, 0, 0); PG8_LDB(B1, 0, 1); PG8_SCHED; PG8_LDA(At, 0, 0); PG8_STAGE(PG8_SA(1, 1), a1 + hstepA, voffA);
            PG8_WAIT_V(8); PG8_WAIT_L(0); PG8_BAR; PG8_MMA(0, 0, At, B0); PG8_MMA(0, 1, At, B1); PG8_BAR; PG8_SCHED;
            PG8_LDA(At, 0, 1); PG8_STAGE(PG8_SB(0, 0), b2, voffB); PG8_STAGE(PG8_SB(0, 1), b2 + hstepB, voffB); PG8_STAGE(PG8_SA(0, 0), a2, voffA);
            PG8_WAIT_V(8); PG8_WAIT_L(0); PG8_BAR; PG8_MMA(1, 0, At, B0); PG8_MMA(1, 1, At, B1); PG8_BAR; PG8_SCHED;
            PG8_LDB(B0, 1, 0); PG8_LDB(B1, 1, 1); PG8_SCHED; PG8_LDA(At, 1, 0); PG8_STAGE(PG8_SA(0, 1), a2 + hstepA, voffA);
            PG8_WAIT_V(8); PG8_WAIT_L(0); PG8_BAR; PG8_MMA(0, 0, At, B0); PG8_MMA(0, 1, At, B1); PG8_BAR; PG8_SCHED;
            PG8_LDA(At, 1, 1); PG8_STAGE(PG8_SB(1, 0), b3, voffB); PG8_STAGE(PG8_SB(1, 1), b3 + hstepB, voffB); PG8_STAGE(PG8_SA(1, 0), a3, voffA);
            PG8_WAIT_V(8); PG8_WAIT_L(0); PG8_BAR; PG8_MMA(1, 0, At, B0); PG8_MMA(1, 1, At, B1); PG8_BAR; PG8_SCHED;
        }
        if (wr == 0) PG8_BAR;
        { const int t_e = fresh_tid(); int fr_e = t_e & 15, fq_e = (t_e >> 4) & 3; int wr_e = wr, wc_e = wc; asm volatile("" : "+s"(wr_e), "+s"(wc_e));
          E(acc, cur, wr_e, wc_e, fr_e, fq_e); }
        if (!has_next) break;
        if (!E.keep(cur)) {
#pragma unroll
            for (int a = 0; a < 2; ++a)
#pragma unroll
                for (int b = 0; b < 2; ++b)
#pragma unroll
                    for (int m = 0; m < 4; ++m)
#pragma unroll
                        for (int n = 0; n < 2; ++n) acc[a][b][m][n] = (f32x4){0.f, 0.f, 0.f, 0.f};
        }
        cur = nxt; cA = nA; cB = nB; ++ui;
        if (wr == 1) PG8_BAR;
    }
    PG8_WAIT_V(0);
    PG8_BAR;
#undef PG8_SA
#undef PG8_SB
#undef PG8_STAGE
#undef PG8_LDA
#undef PG8_LDB
#undef PG8_MMA
#undef PG8_WAIT_V
#undef PG8_WAIT_L
#undef PG8_BAR
#undef PG8_SCHED
#undef PG8_APTR
#undef PG8_BPTR
}
}

template <bool UPMAP = false>
__device__ __forceinline__ void transpose_item(const float* W, int ldw, int ncols, bf16_t* WT, int K, int row_off, LAS float* scr, int item, int lane, const float* gk = nullptr) {
    const int nblk = ncols / 32, kb = item / nblk, nb = item % nblk, k0 = 64 * kb, n0 = 32 * nb;
    if (UPMAP) { const int c2 = n0 < DFF ? n0 : n0 - DFF; row_off = 256 * (c2 >> 7) + (n0 < DFF ? 0 : 128) + (c2 & 127) - n0; }
#pragma unroll
    for (int i = 0; i < 32; ++i) { const int kk = 2 * i + (lane >> 5); float wv = W[(size_t)(k0 + kk) * ldw + n0 + (lane & 31)]; if (gk) wv *= gk[k0 + kk]; scr[kk * 33 + (lane & 31)] = wv; }
    LDS_WAIT(); asm volatile("" ::: "memory");
    const int c = lane & 7;
#pragma unroll
    for (int j = 0; j < 4; ++j) { const int n = (lane >> 3) + 8 * j; const LAS float* s = scr + (8 * c) * 33 + n;
        u32x4 o; o.x = pk2(s[0 * 33], s[1 * 33]); o.y = pk2(s[2 * 33], s[3 * 33]); o.z = pk2(s[4 * 33], s[5 * 33]); o.w = pk2(s[6 * 33], s[7 * 33]);
        *(u32x4*)(WT + (size_t)(row_off + n0 + n) * K + k0 + 8 * c) = o; }
    LDS_WAIT(); asm volatile("" ::: "memory");
}
__device__ __forceinline__ void rms_row_to_bf16(const float* xrow, const float* g, bf16_t* orow, int lane) {
    const f32x4* xr = (const f32x4*)xrow + lane; const f32x4* gr = (const f32x4*)g + lane;
    f32x4 v[4]; float s = 0.f;
#pragma unroll
    for (int j = 0; j < 4; ++j) { v[j] = xr[64 * j]; s += (v[j].x * v[j].x + v[j].y * v[j].y) + (v[j].z * v[j].z + v[j].w * v[j].w); }
    const float rstd = 1.0f / sqrtf(wave_sum(s) * (1.f / DM) + EPS);
    unsigned long long* o8 = (unsigned long long*)orow + lane;
#pragma unroll
    for (int j = 0; j < 4; ++j) { const f32x4 gg = gr[64 * j];
        o8[64 * j] = (unsigned long long)pk2(v[j].x * rstd * gg.x, v[j].y * rstd * gg.y) | ((unsigned long long)pk2(v[j].z * rstd * gg.z, v[j].w * rstd * gg.w) << 32); }
}
__device__ __forceinline__ void rms_2rows_to_bf16(const float* x0, const float* x1, const float* g, bf16_t* o0, bf16_t* o1, int lane) {
    const f32x4* xa = (const f32x4*)x0 + lane; const f32x4* xb = (const f32x4*)x1 + lane; const f32x4* gr = (const f32x4*)g + lane;
    f32x4 va[4], vb[4]; float sa = 0.f, sb = 0.f;
#pragma unroll
    for (int j = 0; j < 4; ++j) { va[j] = xa[64 * j]; vb[j] = xb[64 * j]; }
#pragma unroll
    for (int j = 0; j < 4; ++j) { sa += (va[j].x * va[j].x + va[j].y * va[j].y) + (va[j].z * va[j].z + va[j].w * va[j].w); sb += (vb[j].x * vb[j].x + vb[j].y * vb[j].y) + (vb[j].z * vb[j].z + vb[j].w * vb[j].w); }
    const float ra = 1.0f / sqrtf(wave_sum(sa) * (1.f / DM) + EPS), rb = 1.0f / sqrtf(wave_sum(sb) * (1.f / DM) + EPS);
    unsigned long long* pa = (unsigned long long*)o0 + lane; unsigned long long* pb = (unsigned long long*)o1 + lane;
#pragma unroll
    for (int j = 0; j < 4; ++j) { const f32x4 gg = gr[64 * j];
        pa[64 * j] = (unsigned long long)pk2(va[j].x * ra * gg.x, va[j].y * ra * gg.y) | ((unsigned long long)pk2(va[j].z * ra * gg.z, va[j].w * ra * gg.w) << 32);
        pb[64 * j] = (unsigned long long)pk2(vb[j].x * rb * gg.x, vb[j].y * rb * gg.y) | ((unsigned long long)pk2(vb[j].z * rb * gg.z, vb[j].w * rb * gg.w) << 32); }
}
__device__ __forceinline__ void rms_row_f32_inplace(float* xrow, const float* g, int lane) {
    f32x4* xr = (f32x4*)xrow + lane; const f32x4* gr = (const f32x4*)g + lane;
    f32x4 v[4]; float s = 0.f;
#pragma unroll
    for (int j = 0; j < 4; ++j) { v[j] = xr[64 * j]; s += (v[j].x * v[j].x + v[j].y * v[j].y) + (v[j].z * v[j].z + v[j].w * v[j].w); }
    const float rstd = 1.0f / sqrtf(wave_sum(s) * (1.f / DM) + EPS);
#pragma unroll
    for (int j = 0; j < 4; ++j) { const f32x4 gg = gr[64 * j]; xr[64 * j] = v[j] * rstd * gg; }
}

__device__ __forceinline__ f32x4 mfma16(bf16x8 a, bf16x8 b, f32x4 c) { return __builtin_amdgcn_mfma_f32_16x16x32_bf16(a, b, c, 0, 0, 0); }

template <bool FULL>
__device__ __forceinline__ void gla_segment(LAS unsigned char* L, bf16_t* Z, const float* w_alpha, const float* b_alpha, const float* norm_g, int unit, float* Sbuf, float* Btot) {
    const int tid = fresh_tid(), lane = tid & 63, w = tid >> 6, quad = lane >> 4, l15 = lane & 15;
    const int kcol = tid & 127, qtr = tid >> 7;
    const int b = unit >> 5, h = (unit >> 3) & 3, seg = unit & 7;
    LAS bf16_t* QI = (LAS bf16_t*)(L + 0);
    LAS bf16_t* KI = (LAS bf16_t*)(L + 17408);
    LAS float*  OL = (LAS float*)(L + 0);
    LAS bf16_t* QT = (LAS bf16_t*)(L + 34816);
    LAS bf16_t* KTt = (LAS bf16_t*)(L + 52224);
    LAS bf16_t* Vt = (LAS bf16_t*)(L + 70656);
    LAS bf16_t* Pm = (LAS bf16_t*)(L + 89088);
    LAS bf16_t* St = (LAS bf16_t*)(L + 98304);
    LAS float*  GAs = (LAS float*)(L + 133120);
    LAS float*  PART = (LAS float*)(L + 137216);
    LAS float*  Dd = (LAS float*)(L + 139264);

    float wa[16];
#pragma unroll
    for (int r = 0; r < 16; ++r) wa[r] = w_alpha[r * 512 + h * 128 + kcol] * 1.4426950408889634f;
    const float ba = b_alpha[h * 128 + kcol] * 1.4426950408889634f;
    f32x4 S[8];
#pragma unroll
    for (int t = 0; t < 8; ++t) S[t] = (f32x4){0.f, 0.f, 0.f, 0.f};
    float btot = 0.f;
    if (FULL) {
        if (seg > 0) {
            float cv[32], cb4[4], nv[32], nb4[4];
            { const int up = unit - seg; const float* sb = Sbuf + (size_t)up * 16384 + tid;
#pragma unroll
              for (int j = 0; j < 4; ++j) cb4[j] = Btot[up * 128 + w * 16 + quad * 4 + j];
#pragma unroll
              for (int q = 0; q < 32; ++q) cv[q] = sb[q * 512]; }
            for (int sp = 0; sp < seg; ++sp) {
                const bool hn = sp + 1 < seg; const int upn = unit - seg + (hn ? sp + 1 : sp); const float* sbn = Sbuf + (size_t)upn * 16384 + tid;
#pragma unroll
                for (int j = 0; j < 4; ++j) nb4[j] = Btot[upn * 128 + w * 16 + quad * 4 + j];
#pragma unroll
                for (int q = 0; q < 32; ++q) nv[q] = sbn[q * 512];
                float d[4];
#pragma unroll
                for (int j = 0; j < 4; ++j) d[j] = __builtin_amdgcn_exp2f(cb4[j]);
#pragma unroll
                for (int t = 0; t < 8; ++t)
#pragma unroll
                    for (int j = 0; j < 4; ++j) S[t][j] = S[t][j] * d[j] + cv[t * 4 + j];
#pragma unroll
                for (int j = 0; j < 4; ++j) cb4[j] = nb4[j];
#pragma unroll
                for (int q = 0; q < 32; ++q) cv[q] = nv[q];
            }
        }
#pragma unroll
        for (int t = 0; t < 8; ++t) *(LAS u32x2*)(St + (t * 16 + l15) * 136 + w * 16 + quad * 4) = (u32x2){pk2(S[t][0], S[t][1]), pk2(S[t][2], S[t][3])}    ;
    }
    __syncthreads();

    unsigned short qraw[16], kraw[16], vraw[16], garaw[2], knx[16], vnx[16], ganx[2];
#define GLA_ISSUE(nn) do { const size_t tb_ = (size_t)b * SEQ + (size_t)(seg * 8 + (nn)) * 64; const bf16_t* zq_ = Z + (tb_ + qtr * 16) * ZLD + h * 128 + kcol; \
        _Pragma("unroll") for (int r = 0; r < 16; ++r) { asm volatile("" : "+v"(zq_)); if (FULL) { qraw[r] = zq_[ZQ]; kraw[r] = zq_[ZK]; vraw[r] = zq_[ZV]; } else { knx[r] = zq_[ZK]; vnx[r] = zq_[ZV]; } zq_ += ZLD; } \
        const unsigned short g0_ = Z[(tb_ + (tid >> 4)) * ZLD + ZGA + (tid & 15)], g1_ = Z[(tb_ + 32 + (tid >> 4)) * ZLD + ZGA + (tid & 15)]; \
        if (FULL) { garaw[0] = g0_; garaw[1] = g1_; } else { ganx[0] = g0_; ganx[1] = g1_; } } while (0)
#define GLA_ROTATE() do { if (!FULL) { _Pragma("unroll") for (int r = 0; r < 16; ++r) { kraw[r] = knx[r]; vraw[r] = vnx[r]; } garaw[0] = ganx[0]; garaw[1] = ganx[1]; } } while (0)
    GLA_ISSUE(0); GLA_ROTATE();
    for (int n = 0; n < 8; ++n) {
        const size_t tb = (size_t)b * SEQ + (size_t)(seg * 8 + n) * 64;
        if (!FULL && n + 1 < 8) GLA_ISSUE(n + 1);
        GAs[tid] = bf2f(garaw[0]); GAs[tid + 512] = bf2f(garaw[1]);
        __syncthreads();
        float c[16]; float run = 0.f;
#pragma unroll
        for (int r = 0; r < 16; ++r) { const int i = qtr * 16 + r;
            const LAS f32x4* gp = (const LAS f32x4*)(GAs + i * 16);
            f32x2 a2 = (f32x2){ba, 0.f};
#pragma unroll
            for (int q4 = 0; q4 < 4; ++q4) { const f32x4 g4 = gp[q4];
                a2 = a2 + (f32x2){g4.x, g4.y} * (f32x2){wa[4 * q4], wa[4 * q4 + 1]}; a2 = a2 + (f32x2){g4.z, g4.w} * (f32x2){wa[4 * q4 + 2], wa[4 * q4 + 3]}; }
            const float x = a2.x + a2.y;
            const float ls = fminf(x, 0.f) - __builtin_amdgcn_logf(1.0f + __builtin_amdgcn_exp2f(-fabsf(x)));
            run += ls * (1.0f / 16.0f); c[r] = run; }
        PART[qtr * 128 + kcol] = run;
        __syncthreads();
        const float p0 = PART[kcol], p1 = PART[128 + kcol], p2 = PART[256 + kcol], p3 = PART[384 + kcol];
        const float off = (qtr > 0 ? p0 : 0.f) + (qtr > 1 ? p1 : 0.f) + (qtr > 2 ? p2 : 0.f);
        const float bref = p0 + p1, blast = (p0 + p1) + (p2 + p3);
        btot += blast;
        {
            const float ebr = __builtin_amdgcn_exp2f(bref), elb = __builtin_amdgcn_exp2f(blast - bref);
            unsigned ktp[8], vp[8];
#pragma unroll
            for (int r = 0; r < 16; ++r) { const int i = qtr * 16 + r; const float bi = off + c[r];
                const float e1 = __builtin_amdgcn_exp2f(bi - bref), e1r = __builtin_amdgcn_exp2f(bref - bi);
                const float k = bf2f(kraw[r]); const unsigned vb = vraw[r];
                if (FULL) { const float q = bf2f(qraw[r]) * 0.08838834764831845f;
                    QI[i * 136 + kcol] = (bf16_t)hwbf(q * e1); KI[i * 136 + kcol] = (bf16_t)hwbf(k * e1r); QT[i * 136 + kcol] = (bf16_t)hwbf(q * e1 * ebr); }
                const unsigned kt = hwbf(k * e1r * elb);
                if (r & 1) { ktp[r >> 1] |= kt << 16; vp[r >> 1] |= vb << 16; } else { ktp[r >> 1] = kt; vp[r >> 1] = vb; } }
            *(LAS u32x4*)(KTt + kcol * 72 + qtr * 16) = (u32x4){ktp[0], ktp[1], ktp[2], ktp[3]}; *(LAS u32x4*)(KTt + kcol * 72 + qtr * 16 + 8) = (u32x4){ktp[4], ktp[5], ktp[6], ktp[7]};
            *(LAS u32x4*)(Vt + kcol * 72 + qtr * 16) = (u32x4){vp[0], vp[1], vp[2], vp[3]}; *(LAS u32x4*)(Vt + kcol * 72 + qtr * 16 + 8) = (u32x4){vp[4], vp[5], vp[6], vp[7]};
            if (qtr == 0) Dd[kcol] = __builtin_amdgcn_exp2f(blast);
        }
        __syncthreads();
        if (FULL && n + 1 < 8) GLA_ISSUE(n + 1);
        const int oi = tid >> 3, vs = (tid & 7) * 16;
        bf16_t* zr = Z + (tb + oi) * ZLD + ZR + h * 128 + vs;
        u32x4 g8[2];
        if (FULL) { g8[0] = *(const u32x4*)zr; g8[1] = *(const u32x4*)(zr + 8); }
        if (FULL) {
            {
                const int mi = w >> 1;
#pragma unroll
                for (int nn = 0; nn < 2; ++nn) { const int nj = (w & 1) * 2 + nn; f32x4 a4 = (f32x4){0.f, 0.f, 0.f, 0.f};
#pragma unroll
                    for (int ks = 0; ks < 4; ++ks) a4 = mfma16(*(const LAS bf16x8*)(QI + (mi * 16 + l15) * 136 + ks * 32 + quad * 8), *(const LAS bf16x8*)(KI + (nj * 16 + l15) * 136 + ks * 32 + quad * 8), a4);
#pragma unroll
                    for (int j = 0; j < 4; ++j) { const int i = mi * 16 + quad * 4 + j, jj = nj * 16 + l15; Pm[i * 72 + jj] = (bf16_t)hwbf(jj <= i ? a4[j] : 0.f); } }
            }
            __syncthreads();
            {
                const int mi = w >> 1; f32x4 o4[4];
#pragma unroll
                for (int t = 0; t < 4; ++t) o4[t] = (f32x4){0.f, 0.f, 0.f, 0.f};
#pragma unroll
                for (int ks = 0; ks < 2; ++ks) { const bf16x8 a = *(const LAS bf16x8*)(Pm + (mi * 16 + l15) * 72 + ks * 32 + quad * 8);
#pragma unroll
                    for (int t = 0; t < 4; ++t) { const int nv = (w & 1) * 4 + t; o4[t] = mfma16(a, *(const LAS bf16x8*)(Vt + (nv * 16 + l15) * 72 + ks * 32 + quad * 8), o4[t]); } }
#pragma unroll
                for (int ks = 0; ks < 4; ++ks) { const bf16x8 a = *(const LAS bf16x8*)(QT + (mi * 16 + l15) * 136 + ks * 32 + quad * 8);
#pragma unroll
                    for (int t = 0; t < 4; ++t) { const int nv = (w & 1) * 4 + t; o4[t] = mfma16(a, *(const LAS bf16x8*)(St + (nv * 16 + l15) * 136 + ks * 32 + quad * 8), o4[t]); } }
#pragma unroll
                for (int t = 0; t < 4; ++t) { const int nv = (w & 1) * 4 + t;
#pragma unroll
                    for (int j = 0; j < 4; ++j) OL[(mi * 16 + quad * 4 + j) * 132 + nv * 16 + l15] = o4[t][j]; }
            }
            __syncthreads();
        }
        {
            float dk[4];
#pragma unroll
            for (int j = 0; j < 4; ++j) dk[j] = Dd[w * 16 + quad * 4 + j];
            bf16x8 ka[2];
#pragma unroll
            for (int ks = 0; ks < 2; ++ks) ka[ks] = *(const LAS bf16x8*)(KTt + (w * 16 + l15) * 72 + ks * 32 + quad * 8);
#pragma unroll
            for (int t = 0; t < 8; ++t) {
#pragma unroll
                for (int j = 0; j < 4; ++j) S[t][j] *= dk[j];
#pragma unroll
                for (int ks = 0; ks < 2; ++ks) S[t] = mfma16(ka[ks], *(const LAS bf16x8*)(Vt + (t * 16 + l15) * 72 + ks * 32 + quad * 8), S[t]);
                if (FULL) *(LAS u32x2*)(St + (t * 16 + l15) * 136 + w * 16 + quad * 4) = (u32x2){pk2(S[t][0], S[t][1]), pk2(S[t][2], S[t][3])}    ;
            }
        }
        if (FULL) {
            f32x4 ov[4]; float ss = 0.f;
#pragma unroll
            for (int e = 0; e < 4; ++e) { ov[e] = *(const LAS f32x4*)(OL + oi * 132 + vs + 4 * e); ss += (ov[e].x * ov[e].x + ov[e].y * ov[e].y) + (ov[e].z * ov[e].z + ov[e].w * ov[e].w); }
            ss += __shfl_xor(ss, 1); ss += __shfl_xor(ss, 2); ss += __shfl_xor(ss, 4);
            const float rstd = __builtin_amdgcn_rsqf(ss * (1.0f / 128.0f) + EPS);
            const float* ng = norm_g + h * 128 + vs;
#pragma unroll
            for (int hh = 0; hh < 2; ++hh) {
                const float gr[8] = {bflo(g8[hh].x), bfhi(g8[hh].x), bflo(g8[hh].y), bfhi(g8[hh].y), bflo(g8[hh].z), bfhi(g8[hh].z), bflo(g8[hh].w), bfhi(g8[hh].w)};
                const f32x4 n0 = *(const f32x4*)(ng + 8 * hh), n1 = *(const f32x4*)(ng + 8 * hh + 4);
                const f32x4 a0 = ov[2 * hh], a1 = ov[2 * hh + 1];
                float r8[8];
#pragma unroll
                for (int e = 0; e < 4; ++e) { r8[e] = a0[e] * rstd * n0[e] * siluf_(gr[e]); r8[4 + e] = a1[e] * rstd * n1[e] * siluf_(gr[4 + e]); }
                *(u32x4*)(zr + 8 * hh) = (u32x4){cvt_pk_bf16(r8[0], r8[1]), cvt_pk_bf16(r8[2], r8[3]), cvt_pk_bf16(r8[4], r8[5]), cvt_pk_bf16(r8[6], r8[7])}; }
        }
        if (n + 1 < 8) GLA_ROTATE();
    }
    if (!FULL) {
        float* sb = Sbuf + (size_t)unit * 16384 + tid;
#pragma unroll
        for (int t = 0; t < 8; ++t)
#pragma unroll
            for (int j = 0; j < 4; ++j) sb[(t * 4 + j) * 512] = S[t][j];
        if (qtr == 0) Btot[unit * 128 + kcol] = btot;
    }
    __syncthreads();
}


__device__ __forceinline__ void swa_unit(LAS unsigned char* L, bf16_t* Z, const float* sinks, int b, int qb, int kvh) {
    const int tid = fresh_tid(), lane = tid & 63, w = tid >> 6, quad = lane >> 4, l15 = lane & 15;
    LAS bf16_t* Ks = (LAS bf16_t*)(L + 0);
    LAS bf16_t* Vt = (LAS bf16_t*)(L + 36864);
    LAS bf16_t* Pw = (LAS bf16_t*)(L + 72704 + w * 5376);
    const int t0 = qb * 128; const size_t rowbase = (size_t)b * SEQ;
    const int g = w >> 1, hq = kvh * 4 + g, half = w & 1;
    bf16x8 qf[4][2];
#pragma unroll
    for (int rt = 0; rt < 4; ++rt) { const bf16_t* qp = Z + (rowbase + t0 + 64 * half + 16 * rt + l15) * ZLD + ZSQ + hq * 64 + quad * 8; qf[rt][0] = *(const bf16x8*)qp; qf[rt][1] = *(const bf16x8*)(qp + 32); }
    for (int idx = tid; idx < 2048; idx += NTHREADS) { const int row = idx >> 3, c8 = idx & 7; const int tk = t0 - 128 + row;
        u32x4 v = (u32x4){0u, 0u, 0u, 0u}; if (tk >= 0) v = *(const u32x4*)(Z + (rowbase + tk) * ZLD + ZSK + kvh * 64 + c8 * 8);
        *(LAS u32x4*)(Ks + row * 72 + c8 * 8) = v; }
#pragma unroll
    for (int g = 0; g < 4; ++g) { const int kg = w * 4 + g; unsigned pk[4];
#pragma unroll
        for (int jj = 0; jj < 8; ++jj) { const int tk = t0 - 128 + kg * 8 + jj; unsigned vb = 0u; if (tk >= 0) vb = Z[(rowbase + tk) * ZLD + ZSV + kvh * 64 + lane];
            if (jj & 1) pk[jj >> 1] |= vb << 16; else pk[jj >> 1] = vb; }
        *(LAS u32x4*)(Vt + lane * 280 + kg * 8) = (u32x4){pk[0], pk[1], pk[2], pk[3]}; }
    { unsigned zr; asm volatile("v_mov_b32 %0, 0" : "=v"(zr)); const u32x4 zv = (u32x4){zr, zr, zr, zr};
      if (tid < 128) *(LAS u32x4*)(Vt + (tid >> 1) * 280 + 256 + (tid & 1) * 8) = zv;
      if (lane < 32) *(LAS u32x4*)(Pw + (lane >> 1) * 168 + 144 + (lane & 1) * 8) = zv; }
    __syncthreads();
    const float slope = exp2f(-(float)(hq + 1)) * 1.4426950408889634f; const float sink = sinks[hq] * 1.4426950408889634f;
    const int kmin = (t0 == 0) ? 128 : 0;
#pragma unroll
    for (int rt = 0; rt < 4; ++rt) {
        const int kbase = 64 * half + 16 * rt;
        const bf16x8 qa0 = qf[rt][0], qa1 = qf[rt][1];
        f32x4 sc[9];
#pragma unroll
        for (int n = 0; n < 9; ++n) { const LAS bf16_t* kb = Ks + (kbase + 16 * n + l15) * 72 + quad * 8; f32x4 a4 = (f32x4){0.f, 0.f, 0.f, 0.f};
            a4 = mfma16(qa0, *(const LAS bf16x8*)kb, a4); a4 = mfma16(qa1, *(const LAS bf16x8*)(kb + 32), a4); sc[n] = a4; }
        float mx[4] = {sink, sink, sink, sink};
#pragma unroll
        for (int n = 0; n < 9; ++n)
#pragma unroll
            for (int j = 0; j < 4; ++j) { const int qi = kbase + quad * 4 + j, kk = kbase + 16 * n + l15; const int dist = qi + 128 - kk;
                const bool valid = ((n >= 1 && n <= 7) || ((dist >= 0) && (dist < 128))) && (kk >= kmin);
                const float lg = valid ? sc[n][j] * (0.125f * 1.4426950408889634f) - slope * (float)dist : -INFINITY; sc[n][j] = lg; mx[j] = fmaxf(mx[j], lg); }
#pragma unroll
        for (int j = 0; j < 4; ++j) { mx[j] = fmaxf(mx[j], __shfl_xor(mx[j], 1)); mx[j] = fmaxf(mx[j], __shfl_xor(mx[j], 2)); mx[j] = fmaxf(mx[j], __shfl_xor(mx[j], 4)); mx[j] = fmaxf(mx[j], __shfl_xor(mx[j], 8)); }
        float sum[4] = {0.f, 0.f, 0.f, 0.f};
#pragma unroll
        for (int n = 0; n < 9; ++n)
#pragma unroll
            for (int j = 0; j < 4; ++j) { const float p = __builtin_amdgcn_exp2f(sc[n][j] - mx[j]); sum[j] += p; Pw[(quad * 4 + j) * 168 + 16 * n + l15] = (bf16_t)hwbf(p); }
        float rden[4];
#pragma unroll
        for (int j = 0; j < 4; ++j) { sum[j] += __shfl_xor(sum[j], 1); sum[j] += __shfl_xor(sum[j], 2); sum[j] += __shfl_xor(sum[j], 4); sum[j] += __shfl_xor(sum[j], 8);
            rden[j] = __builtin_amdgcn_rcpf(sum[j] + __builtin_amdgcn_exp2f(sink - mx[j])); }
        asm volatile("s_waitcnt lgkmcnt(0)" ::: "memory");
        f32x4 o4[4];
#pragma unroll
        for (int nd = 0; nd < 4; ++nd) o4[nd] = (f32x4){0.f, 0.f, 0.f, 0.f};
#pragma unroll
        for (int ks = 0; ks < 5; ++ks) { const bf16x8 a = *(const LAS bf16x8*)(Pw + l15 * 168 + ks * 32 + quad * 8);
#pragma unroll
            for (int nd = 0; nd < 4; ++nd) o4[nd] = mfma16(a, *(const LAS bf16x8*)(Vt + (nd * 16 + l15) * 280 + kbase + ks * 32 + quad * 8), o4[nd]); }
#pragma unroll
        for (int nd = 0; nd < 4; ++nd)
#pragma unroll
            for (int j = 0; j < 4; ++j) Z[(rowbase + t0 + kbase + quad * 4 + j) * ZLD + ZSQ + hq * 64 + nd * 16 + l15] = (bf16_t)hwbf(o4[nd][j] * rden[j]);
        asm volatile("s_waitcnt lgkmcnt(0)" ::: "memory");
    }
    __syncthreads();
}


#define XB_TMO      128
#define XB_XCNT(j)  (256  + 64 * (j))
#define XB_XSUB(j)  (1280 + 64 * (j))
#define XB_XGEN(j)  (2304 + 64 * (j))
#define XB_TOP      3328
#define XB_TOPGEN   3392
#define XCD_BAR_WORDS 3456
#define XB_SPIN_CAP (1u << 18)
__device__ __forceinline__ unsigned xb_ld(unsigned* p)              { return __hip_atomic_load(p, __ATOMIC_RELAXED, __HIP_MEMORY_SCOPE_AGENT); }
__device__ __forceinline__ unsigned xb_add(unsigned* p, unsigned v) { return __hip_atomic_fetch_add(p, v, __ATOMIC_RELAXED, __HIP_MEMORY_SCOPE_AGENT); }
__device__ __forceinline__ unsigned xb_xcc_id() { return (unsigned)__builtin_amdgcn_s_getreg((3 << 11) | 20) & 0xFu; }
#define XB_SPIN(cond, bar) do { unsigned _sp = 0; while (cond) { __builtin_amdgcn_s_sleep(1); \
    if ((++_sp & 255u) == 0u) { if (xb_ld(&(bar)[XB_TMO])) break; if (_sp > XB_SPIN_CAP) { atomicAdd(&(bar)[XB_TMO], 1u); break; } } } } while (0)
struct XcdBarrier { unsigned* bar; unsigned x; volatile LAS unsigned* st; };
__device__ __forceinline__ XcdBarrier xcd_barrier_post(unsigned* bar, volatile LAS unsigned* st) {
    XcdBarrier b; b.bar = bar; b.x = xb_xcc_id(); b.st = st;
    if (threadIdx.x == 0) (void)xb_add(&bar[XB_XCNT(b.x)], 1u);
    return b;
}
__device__ __forceinline__ void xcd_barrier_complete(unsigned* bar, unsigned x, unsigned& nloc, unsigned& nx) {
    const unsigned G = gridDim.x * gridDim.y * gridDim.z;
    unsigned sum, cnt, mine, sp = 0u;
    for (;;) {
        sum = 0u; cnt = 0u; mine = 0u;
#pragma unroll
        for (unsigned j = 0; j < 16; ++j) { const unsigned c = xb_ld(&bar[XB_XCNT(j)]); sum += c; cnt += (c > 0u) ? 1u : 0u; mine = (j == x) ? c : mine; }
        if (sum == G) break;
        __builtin_amdgcn_s_sleep(1);
        if ((++sp & 255u) == 0u) { if (xb_ld(&bar[XB_TMO])) break; if (sp > XB_SPIN_CAP) { atomicAdd(&bar[XB_TMO], 1u); break; } }
    }
    nloc = mine > 0u ? mine : 1u; nx = cnt > 0u ? cnt : 1u;
}
__device__ __forceinline__ void xcd_barrier(const XcdBarrier& b) {
    asm volatile("s_waitcnt vmcnt(0)" ::: "memory");
    __syncthreads();
    if (threadIdx.x == 0) {
        unsigned* bar = b.bar; asm volatile("" : "+s"(bar));
        __builtin_amdgcn_s_waitcnt(0);
        unsigned nloc = b.st[0], nx = b.st[1];
        if (nloc == 0u) { xcd_barrier_complete(bar, b.x, nloc, nx); b.st[0] = nloc; b.st[1] = nx; }
        const unsigned old = xb_add(&bar[XB_XSUB(b.x)], 1u);
        const unsigned gen = old / nloc;
        if (old + 1u == (gen + 1u) * nloc) {
            __builtin_amdgcn_fence(__ATOMIC_RELEASE, "agent");
            asm volatile("s_waitcnt vmcnt(0)" ::: "memory");
            const unsigned og = xb_add(&bar[XB_TOP], 1u);
            const unsigned tg = og / nx;
            if (og + 1u == (tg + 1u) * nx) xb_add(&bar[XB_TOPGEN], 1u);
            else XB_SPIN(xb_ld(&bar[XB_TOPGEN]) == tg, bar);
            __builtin_amdgcn_fence(__ATOMIC_ACQUIRE, "agent");
            xb_add(&bar[XB_XGEN(b.x)], 1u);
            asm volatile("s_waitcnt vmcnt(0)" ::: "memory");
        } else {
            XB_SPIN(xb_ld(&bar[XB_XGEN(b.x)]) == gen, bar);
            __builtin_amdgcn_fence(__ATOMIC_ACQUIRE, "agent");
            asm volatile("s_waitcnt vmcnt(0)" ::: "memory");
        }
    }
    __syncthreads();
}

struct Args { const float* in[17]; float* out; unsigned char* ws; };

__global__ void __launch_bounds__(NTHREADS, 2) mega_fwd(Args args) {
    extern __shared__ __attribute__((aligned(16))) unsigned char lds_raw[];
    LAS unsigned char* lds = (LAS unsigned char*)lds_raw;
    cg::grid_group grid = cg::this_grid();
    const int G = gridDim.x, blk = blockIdx.x, NGW = G * 8;
#define FRESH_IDS() const int tid = fresh_tid(), lane = tid & 63, wave = __builtin_amdgcn_readfirstlane(tid >> 6), gw = blk * 8 + wave; (void)lane; (void)gw
    const float* x = args.in[0]; float* out = args.out;
    bf16_t* Wb = (bf16_t*)(args.ws + WS_W);
    bf16_t* U = (bf16_t*)(args.ws + WS_U);
    bf16_t* Z = (bf16_t*)(args.ws + WS_BIG);
    bf16_t* MRG = (bf16_t*)(args.ws + WS_BIG + 288 * MiB);
    float* SSQ = (float*)(args.ws + WS_SSQ);
    bf16_t* ACT = (bf16_t*)(args.ws + WS_BIG);
    float* PRE = (float*)(args.ws + WS_BIG + 176 * MiB);

    volatile LAS unsigned* MISC = (volatile LAS unsigned*)(lds + LDS_BYTES - 64);
    unsigned* barw = (unsigned*)(args.ws + WS_BAR);
    { FRESH_IDS(); if (tid < 16) MISC[tid] = 0u;
    }
    __syncthreads();
    const XcdBarrier xbar = xcd_barrier_post(barw, MISC + 8);
#define GRID_BAR() xcd_barrier(xbar)
    {
        FRESH_IDS();
        LAS float* scr = (LAS float*)(lds + wave * 16384);
        constexpr int I_A = 16 * 64, I_B = 16 * 72, I_G = 16 * 96, I_P = 8 * 32, I_O = 16 * 32, I_UP = 16 * 176, I_DN = 44 * 32;
        constexpr int I_LAYER = I_A + I_B + I_G + 3 * I_P + I_O + I_UP + I_DN;
        for (int it = gw; it < 2 * I_LAYER; it += NGW) {
            const int l = it / I_LAYER; int r = it - l * I_LAYER;
            bf16_t* WL = Wb + (size_t)l * LAYER_W;
            const float* w_in = args.in[2] + (size_t)l * DM * DIN;
            if (r < I_A) { transpose_item(w_in, DIN, 2048, WL + OW_IN, DM, 0, scr, r, lane, args.in[1] + l * DM); continue; } r -= I_A;
            if (r < I_B) { transpose_item(w_in + 2064, DIN, 2304, WL + OW_IN, DM, 2048, scr, r, lane, args.in[1] + l * DM); continue; } r -= I_B;
            if (r < I_G) { transpose_item(w_in + 4368, DIN, 3072, WL + OW_G, DM, 0, scr, r, lane, args.in[1] + l * DM); continue; } r -= I_G;
            if (r < I_P) { transpose_item(args.in[8] + (size_t)l * 512 * DM, DM, DM, WL + OW_GLA, 512, 0, scr, r, lane); continue; } r -= I_P;
            if (r < I_P) { transpose_item(args.in[9] + (size_t)l * 512 * DM, DM, DM, WL + OW_CONV, 512, 0, scr, r, lane); continue; } r -= I_P;
            if (r < I_P) { transpose_item(args.in[10] + (size_t)l * 512 * DM, DM, DM, WL + OW_SWA, 512, 0, scr, r, lane); continue; } r -= I_P;
            if (r < I_O) { transpose_item(args.in[11] + (size_t)l * DM * DM, DM, DM, WL + OW_O, DM, 0, scr, r, lane); continue; } r -= I_O;
            if (r < I_UP) { transpose_item<true>(args.in[13] + (size_t)l * DM * DFF2, DFF2, DFF2, WL + OW_UP, DM, 0, scr, r, lane, args.in[12] + l * DM); continue; } r -= I_UP;
            transpose_item(args.in[15] + (size_t)l * DFF * DM, DM, DM, WL + OW_DN, DFF, 0, scr, r, lane);
        }
        for (int idx = blk * NTHREADS + tid; idx < 2 * 256 * DM; idx += G * NTHREADS) {
            const int l = idx / (256 * DM), rem = idx - l * 256 * DM, row = rem >> 10, k = rem & 1023;
            const float v = row < 16 ? args.in[2][(size_t)l * DM * DIN + (size_t)k * DIN + 2048 + row] * args.in[1][l * DM + k] : 0.f;
            Wb[(size_t)l * LAYER_W + OW_IN + (size_t)(4352 + row) * DM + k] = (bf16_t)f2bf(v);
        }
        for (int m = gw; m < T; m += 4 * NGW) {
            f32x4 v[4][4]; float sq[4];
#pragma unroll
            for (int h4 = 0; h4 < 4; ++h4) { const int mm = m + h4 * NGW; const f32x4* xr = (const f32x4*)(x + (size_t)(mm < T ? mm : m) * DM) + lane;
#pragma unroll
                for (int j = 0; j < 4; ++j) v[h4][j] = xr[64 * j]; }
#pragma unroll
            for (int h4 = 0; h4 < 4; ++h4) { float q = 0.f;
#pragma unroll
                for (int j = 0; j < 4; ++j) q += (v[h4][j].x * v[h4][j].x + v[h4][j].y * v[h4][j].y) + (v[h4][j].z * v[h4][j].z + v[h4][j].w * v[h4][j].w);
                sq[h4] = q; }
#pragma unroll
            for (int o = 1; o < 64; o <<= 1) {
#pragma unroll
                for (int h4 = 0; h4 < 4; ++h4) sq[h4] += __shfl_xor(sq[h4], o); }
#pragma unroll
            for (int h4 = 0; h4 < 4; ++h4) { const int mm = m + h4 * NGW; if (mm < T) {
                unsigned long long* o8 = (unsigned long long*)(U + (size_t)mm * DM) + lane;
#pragma unroll
                for (int j = 0; j < 4; ++j) o8[64 * j] = (unsigned long long)pk2(v[h4][j].x, v[h4][j].y) | ((unsigned long long)pk2(v[h4][j].z, v[h4][j].w) << 32);
                if (lane < 4) *(f32x4*)(SSQ + ((size_t)lane * T + mm) * 4) = (f32x4){lane == 0 ? sq[h4] : 0.f, 0.f, 0.f, 0.f}; } }
        }
    }
    GRID_BAR();
    if (G == 0x7fffffff) grid.sync();

    for (int l = 0; l < 2; ++l) {
        const bf16_t* WL = Wb + (size_t)l * LAYER_W;
        {
            pg8::Gemm g{U, U, U, WL + OW_IN, WL + OW_IN, WL + OW_IN};
            pg8::StaticOrder<1, ZLD> S; S.init(G, blk);
            pg8::EpiBf16<0> E{Z, ZLD, SSQ};
            if (PHM & 16) pg8::gemm_phase<pg8::EpiBf16<0>, pg8::StaticOrder<1, ZLD>, 1, DM, DM, DM>(lds, g, S, E);
        }
        GRID_BAR();
        {
            float* Sbuf = (float*)(args.ws + WS_SBUF); float* Btot = (float*)(args.ws + WS_BTOT);
            if (PHM & 1) for (int u = blk; u < 256; u += G) gla_segment<false>(lds, Z, args.in[3] + (size_t)l * 16 * 512, args.in[4] + (size_t)l * 512, args.in[5] + (size_t)l * 512, u, Sbuf, Btot);
            for (int u = blk; u < NB * 32 * 2; u += G) { const int kvh = u & 1, qb = (u >> 1) & 31, b = u >> 6; if (PHM & 2) swa_unit(lds, Z, args.in[7] + l * 8, b, qb, kvh); }
        }
        GRID_BAR();
        {
            float* Sbuf = (float*)(args.ws + WS_SBUF); float* Btot = (float*)(args.ws + WS_BTOT);
            if (PHM & 1) for (int u = blk; u < 256; u += G) gla_segment<true>(lds, Z, args.in[3] + (size_t)l * 16 * 512, args.in[4] + (size_t)l * 512, args.in[5] + (size_t)l * 512, u, Sbuf, Btot);
            FRESH_IDS();
            const float* cw = args.in[6] + (size_t)l * 3 * 512;
            if (PHM & 4) for (int it = blk * NTHREADS + tid; it < (T / 4) * 64; it += G * NTHREADS) {
                const int tg = it >> 6, c8 = it & 63, t0 = tg * 4; const bool has_prev = (t0 & (SEQ - 1)) != 0;
                bf16_t* zp = Z + (size_t)t0 * ZLD + c8 * 8;
                const u32x4 z4 = (u32x4){0u, 0u, 0u, 0u};
                u32x4 xm2 = z4, cm2 = z4, xm1 = z4, cm1 = z4, xr[4], cr[4], br[4];
                if (has_prev) { xm2 = *(const u32x4*)(zp - 2 * ZLD + ZCX); cm2 = *(const u32x4*)(zp - 2 * ZLD + ZCC); xm1 = *(const u32x4*)(zp - ZLD + ZCX); cm1 = *(const u32x4*)(zp - ZLD + ZCC); }
#pragma unroll
                for (int q = 0; q < 4; ++q) { xr[q] = *(const u32x4*)(zp + (size_t)q * ZLD + ZCX); cr[q] = *(const u32x4*)(zp + (size_t)q * ZLD + ZCC); br[q] = *(const u32x4*)(zp + (size_t)q * ZLD + ZCB); }
                float w0[8], w1[8], w2[8], p2[8], p1[8];
#pragma unroll
                for (int e = 0; e < 8; ++e) { w0[e] = cw[c8 * 8 + e]; w1[e] = cw[512 + c8 * 8 + e]; w2[e] = cw[1024 + c8 * 8 + e]; }
#pragma unroll
                for (int e = 0; e < 4; ++e) { p2[2 * e] = bflo(xm2[e]) * bflo(cm2[e]); p2[2 * e + 1] = bfhi(xm2[e]) * bfhi(cm2[e]); p1[2 * e] = bflo(xm1[e]) * bflo(cm1[e]); p1[2 * e + 1] = bfhi(xm1[e]) * bfhi(cm1[e]); }
#pragma unroll
                for (int q = 0; q < 4; ++q) { float p0[8]; unsigned res[4];
#pragma unroll
                    for (int e = 0; e < 4; ++e) { p0[2 * e] = bflo(xr[q][e]) * bflo(cr[q][e]); p0[2 * e + 1] = bfhi(xr[q][e]) * bfhi(cr[q][e]); }
#pragma unroll
                    for (int e = 0; e < 4; ++e) {
                        const float lo = bflo(br[q][e]) * (w0[2 * e] * p2[2 * e] + w1[2 * e] * p1[2 * e] + w2[2 * e] * p0[2 * e]);
                        const float hi = bfhi(br[q][e]) * (w0[2 * e + 1] * p2[2 * e + 1] + w1[2 * e + 1] * p1[2 * e + 1] + w2[2 * e + 1] * p0[2 * e + 1]);
                        res[e] = pk2(lo, hi); }
                    *(u32x4*)(zp + (size_t)q * ZLD + ZCB) = (u32x4){res[0], res[1], res[2], res[3]};
#pragma unroll
                    for (int e = 0; e < 8; ++e) { p2[e] = p1[e]; p1[e] = p0[e]; } }
            }
        }
        GRID_BAR();
        {
            pg8::Gemm g{U, U, U, WL + OW_G, WL + OW_G, WL + OW_G};
            pg8::StaticOrder<1, 3072> S; S.init(G, blk);
            pg8::EpiBf16<1> E{Z, ZLD, SSQ};
            if (PHM & 32) pg8::gemm_phase<pg8::EpiBf16<1>, pg8::StaticOrder<1, 3072>, 1, DM, DM, DM>(lds, g, S, E);
        }
        GRID_BAR();
        {
            pg8::Gemm g{Z + ZR, Z + ZCB, Z + ZSQ, WL + OW_GLA, WL + OW_CONV, WL + OW_SWA};
            pg8::StaticOrder<3, DM> S; S.init(G, blk);
            pg8::EpiMerge E{Z, MRG, DM};
            if (PHM & 64) pg8::gemm_phase<pg8::EpiMerge, pg8::StaticOrder<3, DM>, 3, 512, ZLD, 512>(lds, g, S, E);
        }
        GRID_BAR();
        {
            pg8::Gemm g{MRG, MRG, MRG, WL + OW_O, WL + OW_O, WL + OW_O};
            pg8::StaticOrder<1, DM> S; S.init(G, blk);
            pg8::EpiResid E{(const float*)nullptr, U, (float*)nullptr, DM, U, SSQ};
            if (PHM & 128) pg8::gemm_phase<pg8::EpiResid, pg8::StaticOrder<1, DM>, 1, DM, DM, DM>(lds, g, S, E);
        }
        GRID_BAR();
        {
            pg8::Gemm g{U, U, U, WL + OW_UP, WL + OW_UP, WL + OW_UP};
            pg8::StaticOrder<1, DFF2> S; S.init(G, blk);
            pg8::EpiAct E{ACT, PRE, args.in[14] + (size_t)l * 3 * DFF2, lds + 131072, SSQ};
            if (PHM & 16) pg8::gemm_phase<pg8::EpiAct, pg8::StaticOrder<1, DFF2>, 1, DM, DM, DM>(lds, g, S, E);
        }
        GRID_BAR();
        {
            pg8::Gemm g{ACT, ACT, ACT, WL + OW_DN, WL + OW_DN, WL + OW_DN};
            pg8::StaticOrder<1, DM> S; S.init(G, blk);
            {
                FRESH_IDS();
                const float* fw = args.in[14] + (size_t)l * 3 * DFF2;
                pg8::Unit fu;
                for (int i = 0; S.next(i, fu); ++i) {
                    const int pm = fu.pm; const bool first = (pm & 15) == 0;
                    const float* P0 = PRE + (size_t)pm * 4 * DFF2; const float* Pp = PRE + (size_t)(pm - 1) * 4 * DFF2;
                    float fx0[6][2], fx1[6][2], fm2[6][2], fm1[6][2], fw0[6][2], fw1[6][2], fw2[6][2];
#pragma unroll
                    for (int k = 0; k < 6; ++k) { const int c = tid + k * NTHREADS;
#pragma unroll
                        for (int hbj = 0; hbj < 2; ++hbj) { const int cc = (c < DFF ? c : tid) + hbj * DFF;
                            fx0[k][hbj] = P0[cc]; fx1[k][hbj] = P0[DFF2 + cc]; fm2[k][hbj] = first ? 0.f : Pp[2 * DFF2 + cc]; fm1[k][hbj] = first ? 0.f : Pp[3 * DFF2 + cc];
                            fw0[k][hbj] = fw[cc]; fw1[k][hbj] = fw[DFF2 + cc]; fw2[k][hbj] = fw[2 * DFF2 + cc]; } }
#pragma unroll
                    for (int k = 0; k < 6; ++k) { const int c = tid + k * NTHREADS;
                        if (c < DFF) {
                            const float ra0 = fw0[k][0] * fm2[k][0] + fw1[k][0] * fm1[k][0] + fw2[k][0] * fx0[k][0], ra1 = fw0[k][0] * fm1[k][0] + fw1[k][0] * fx0[k][0] + fw2[k][0] * fx1[k][0];
                            const float rb0 = fw0[k][1] * fm2[k][1] + fw1[k][1] * fm1[k][1] + fw2[k][1] * fx0[k][1], rb1 = fw0[k][1] * fm1[k][1] + fw1[k][1] * fx0[k][1] + fw2[k][1] * fx1[k][1];
                            ACT[(size_t)(pm * 256) * DFF + c] = (bf16_t)f2bf(siluf_(ra0) * rb0);
                            ACT[(size_t)(pm * 256 + 1) * DFF + c] = (bf16_t)f2bf(siluf_(ra1) * rb1); } }
                }
                asm volatile("s_waitcnt vmcnt(0)" ::: "memory");
                __syncthreads();
                if (tid == 0) { __builtin_amdgcn_fence(__ATOMIC_ACQUIRE, "agent"); asm volatile("s_waitcnt vmcnt(0)" ::: "memory"); }
                __syncthreads();
            }
            pg8::EpiResid E{(const float*)nullptr, U, (float*)nullptr, DM, U, SSQ};
            if (PHM & 128) pg8::gemm_phase<pg8::EpiResid, pg8::StaticOrder<1, DM>, 1, DFF, DFF, DFF>(lds, g, S, E);
        }
        GRID_BAR();
    }
    { FRESH_IDS();
      const f32x4* gr = (const f32x4*)args.in[16] + lane;
      for (int m = gw; m < T; m += 4 * NGW) {
          u32x2 v[4][4]; f32x4 pq[4][4];
#pragma unroll
          for (int h4 = 0; h4 < 4; ++h4) { const int mm = (m + h4 * NGW) < T ? (m + h4 * NGW) : m; const u32x2* hr = (const u32x2*)(U + (size_t)mm * DM) + lane;
#pragma unroll
              for (int j = 0; j < 4; ++j) { v[h4][j] = hr[64 * j]; pq[h4][j] = *(const f32x4*)(SSQ + ((size_t)j * T + mm) * 4); } }
#pragma unroll
          for (int h4 = 0; h4 < 4; ++h4) { const int mm = m + h4 * NGW; if (mm < T) {
              float sq = 0.f;
#pragma unroll
              for (int j = 0; j < 4; ++j) sq += (pq[h4][j].x + pq[h4][j].y) + (pq[h4][j].z + pq[h4][j].w);
              const float rstd = __builtin_amdgcn_rsqf(sq * (1.f / DM) + EPS); f32x4* xw = (f32x4*)(out + (size_t)mm * DM) + lane;
#pragma unroll
              for (int j = 0; j < 4; ++j) { const f32x4 hv = (f32x4){bflo(v[h4][j].x), bfhi(v[h4][j].x), bflo(v[h4][j].y), bfhi(v[h4][j].y)}; xw[64 * j] = hv * rstd * gr[64 * j]; } } }
      }
    }
}

extern "C" void kernel_launch(void* const* d_in, const int* in_sizes, int n_in, void* d_out, int out_size, void* d_ws, size_t ws_size, hipStream_t stream) {
    static int grid_blocks = 0;
    if (grid_blocks == 0) {
        if (n_in != 17 || out_size != T * DM || ws_size < WS_END) { fprintf(stderr, "kernel_launch: unexpected shapes (n_in %d out %d ws %zu)\n", n_in, out_size, ws_size); grid_blocks = -1; return; }
        int dev = 0, cus = 0, per_cu = 0;
        hipGetDevice(&dev);
        hipDeviceGetAttribute(&cus, hipDeviceAttributeMultiprocessorCount, dev);
        if (hipFuncSetAttribute((const void*)mega_fwd, hipFuncAttributeMaxDynamicSharedMemorySize, LDS_BYTES) != hipSuccess) { fprintf(stderr, "kernel_launch: hipFuncSetAttribute failed\n"); grid_blocks = -1; return; }
        if (hipOccupancyMaxActiveBlocksPerMultiprocessor(&per_cu, (const void*)mega_fwd, NTHREADS, LDS_BYTES) != hipSuccess || per_cu < 1) { fprintf(stderr, "kernel_launch: occupancy query says %d\n", per_cu); per_cu = 1; }
        (void)hipGetLastError();
        grid_blocks = cus * (per_cu > 1 ? 1 : per_cu);
        fprintf(stderr, "kernel_launch: grid %d (cus %d, per_cu %d), ws %zu\n", grid_blocks, cus, per_cu, ws_size);
    }
    if (grid_blocks < 0) return;
    Args a{};
    for (int i = 0; i < 17; ++i) a.in[i] = (const float*)d_in[i];
    a.out = (float*)d_out; a.ws = (unsigned char*)d_ws;
    void* kargs[] = {&a};
    if (hipMemsetAsync((unsigned char*)d_ws + WS_BAR, 0, XCD_BAR_WORDS * 4, stream) != hipSuccess) { fprintf(stderr, "kernel_launch: memset of the barrier words failed\n"); return; }
    hipError_t e = hipLaunchCooperativeKernel((const void*)mega_fwd, dim3(grid_blocks), dim3(NTHREADS), kargs, LDS_BYTES, stream);
    if (e != hipSuccess) fprintf(stderr, "kernel_launch: cooperative launch failed: %s (grid %d)\n", hipGetErrorString(e), grid_blocks);
}
```
